# Optimizing an MI355X kernel written in HIP

```python
import math
import jax, jax.numpy as jnp
from jax import lax
import numpy as np

D_MODEL = 1024
BATCH = 8
SEQ = 2048
DEPTH = 1
DEC_BATCH = 16
DEC_SEQ = 2048
PAST_LEN = 128

GRID_W = 64
N_MEM = 256
MLSTM_HEADS = 4
MLSTM_DH = D_MODEL // 8
MLSTM_W = MLSTM_HEADS * MLSTM_DH
MLSTM_CHUNK = 128
ATTN_DH = 128
ATTN_HEADS = D_MODEL // ATTN_DH
KV_HEADS = 2
ATTN_GROUP = ATTN_HEADS // KV_HEADS
ATTN_W = ATTN_HEADS * ATTN_DH
Q_BLOCK = 128
ROPE_AXIS_DIM = ATTN_DH // 2
ROPE_THETA = 10000.0
MEM_HEADS = 4
MEM_DH = 128
MEM_W = MEM_HEADS * MEM_DH
N_BRANCH = 3
D_FF = ((8 * D_MODEL // 3 + 127) // 128) * 128
CONV_W = 3
DEEPNORM_ALPHA = (2.0 * DEPTH) ** 0.25
DEEPNORM_BETA = (8.0 * DEPTH) ** -0.25
LN_EPS = 1e-5
IN_SPLITS = (MLSTM_W, MLSTM_W, MLSTM_W, MLSTM_W, 4 * MLSTM_HEADS,
             ATTN_W, KV_HEADS * ATTN_DH, KV_HEADS * ATTN_DH, MEM_W, N_BRANCH * D_MODEL)
IN_W = sum(IN_SPLITS)

kernel_name = "hybrid_mlstm_gqa_mem_encoder"


def layer_norm(x, g, b):
    xf = x.astype(jnp.float32)
    mu = jnp.mean(xf, axis=-1, keepdims=True)
    xc = xf - mu
    var = jnp.mean(xc * xc, axis=-1, keepdims=True)
    return (xc * lax.rsqrt(var + LN_EPS) * g.astype(jnp.float32) + b.astype(jnp.float32)).astype(x.dtype)


def rms_norm(x, g):
    xf = x.astype(jnp.float32)
    return (xf * lax.rsqrt(jnp.mean(xf * xf, axis=-1, keepdims=True) + LN_EPS) * g.astype(jnp.float32)).astype(x.dtype)


def split_cols(x, sizes):
    out, start = [], 0
    for s in sizes:
        out.append(x[..., start:start + s])
        start += s
    return out


def dwconv_centred(x, w, b):
    T = x.shape[1]
    pad = CONV_W // 2
    xp = jnp.pad(x, ((0, 0), (pad, pad), (0, 0)))
    y = xp[:, 0:T] * w[0] + b
    for j in range(1, CONV_W):
        y = y + xp[:, j:j + T] * w[j]
    return y


def mlstm_chunkwise(q, k, v, log_i, log_f):
    B, T, H, dk = q.shape
    L = MLSTM_CHUNK
    NC = T // L

    def chunks(a):
        return jnp.moveaxis(a.reshape(B, NC, L, H, -1), 3, 1)

    q = chunks(q)
    k = chunks(k) * (dk ** -0.5)
    v = chunks(v)
    li = chunks(log_i[..., None])[..., 0]
    lf = chunks(log_f[..., None])[..., 0]
    bl = jnp.cumsum(lf, axis=-1)
    g = bl[..., -1]

    a = g[..., None] - bl + li
    ma = jnp.max(a, axis=-1)
    wa = jnp.exp(a - ma[..., None])
    kv_chunk = jnp.einsum('bhcl,bhcld,bhcle->bhcde', wa, k, v)
    n_chunk = jnp.einsum('bhcl,bhcld->bhcd', wa, k)

    def step(carry, inp):
        C, n, m = carry
        kv_c, n_c, g_c, ma_c = inp
        m_new = jnp.maximum(g_c + m, ma_c)
        sp = jnp.exp(g_c + m - m_new)
        sc = jnp.exp(ma_c - m_new)
        C_new = sp[..., None, None] * C + sc[..., None, None] * kv_c
        n_new = sp[..., None] * n + sc[..., None] * n_c
        return (C_new, n_new, m_new), (C, n, m)

    init = (jnp.zeros((B, H, dk, v.shape[-1]), jnp.float32),
            jnp.zeros((B, H, dk), jnp.float32),
            jnp.zeros((B, H), jnp.float32))
    xs = (jnp.moveaxis(kv_chunk, 2, 0), jnp.moveaxis(n_chunk, 2, 0),
          jnp.moveaxis(g, 2, 0), jnp.moveaxis(ma, 2, 0))
    _, (C_prev, n_prev, m_prev) = lax.scan(step, init, xs)
    C_prev = jnp.moveaxis(C_prev, 0, 2)
    n_prev = jnp.moveaxis(n_prev, 0, 2)
    m_prev = jnp.moveaxis(m_prev, 0, 2)

    D = bl[..., :, None] - bl[..., None, :] + li[..., None, :]
    mask = jnp.tril(jnp.ones((L, L), dtype=bool))
    D = jnp.where(mask, D, -jnp.inf)
    inter_log = bl + m_prev[..., None]
    m_t = jnp.maximum(inter_log, jnp.max(D, axis=-1))
    s = jnp.einsum('bhctd,bhcsd->bhcts', q, k) * jnp.exp(D - m_t[..., None])
    w_inter = jnp.exp(inter_log - m_t)
    num = (jnp.einsum('bhcts,bhcse->bhcte', s, v)
           + w_inter[..., None] * jnp.einsum('bhctd,bhcde->bhcte', q, C_prev))
    den = jnp.sum(s, axis=-1) + w_inter * jnp.einsum('bhctd,bhcd->bhct', q, n_prev)
    h = num / jnp.maximum(jnp.abs(den), jnp.exp(-m_t))[..., None]
    return jnp.moveaxis(h, 1, 3).reshape(B, T, H, -1)


def bidirectional_mlstm(q, k, v, gate_pre):
    B, T, H, _ = q.shape
    gt = gate_pre.reshape(B, T, 4, H)
    h_f = mlstm_chunkwise(q, k, v, gt[:, :, 0], jax.nn.log_sigmoid(gt[:, :, 1]))
    flip = lambda a: a[:, ::-1]
    h_b = flip(mlstm_chunkwise(flip(q), flip(k), flip(v), flip(gt[:, :, 2]),
                               flip(jax.nn.log_sigmoid(gt[:, :, 3]))))
    return h_f + h_b


def head_layer_norm(h, g):
    B, T, H, dv = h.shape
    mu = jnp.mean(h, axis=-1, keepdims=True)
    hc = h - mu
    var = jnp.mean(hc * hc, axis=-1, keepdims=True)
    return (hc * lax.rsqrt(var + LN_EPS)).reshape(B, T, H * dv) * g.astype(jnp.float32)


def axial_rope_angles(T):
    rows = T // GRID_W
    row = jnp.repeat(jnp.arange(rows, dtype=jnp.float32), GRID_W)
    col = jnp.tile(jnp.arange(GRID_W, dtype=jnp.float32), rows)
    inv_freq = ROPE_THETA ** (-jnp.arange(0, ROPE_AXIS_DIM, 2, dtype=jnp.float32) / ROPE_AXIS_DIM)
    return row[:, None] * inv_freq, col[:, None] * inv_freq


def rotate_axis(x, ang):
    cos = jnp.cos(ang)[None, :, None, :]
    sin = jnp.sin(ang)[None, :, None, :]
    half = ROPE_AXIS_DIM // 2
    x1, x2 = x[..., :half], x[..., half:]
    return jnp.concatenate([x1 * cos - x2 * sin, x2 * cos + x1 * sin], axis=-1)


def apply_axial_rope(x, ang_row, ang_col):
    xf = x.astype(jnp.float32)
    out = jnp.concatenate([rotate_axis(xf[..., :ROPE_AXIS_DIM], ang_row),
                           rotate_axis(xf[..., ROPE_AXIS_DIM:], ang_col)], axis=-1)
    return out.astype(x.dtype)


def blocked_attention(q, k, v):
    B, T, Hkv, G, dh = q.shape
    NB = T // Q_BLOCK
    qb = jnp.moveaxis(q.reshape(B, NB, Q_BLOCK, Hkv, G, dh), 1, 0)
    scale = dh ** -0.5

    def one_block(qblk):
        s = jnp.einsum('bqhgd,bkhd->bhgqk', qblk, k).astype(jnp.float32) * scale
        p = jax.nn.softmax(s, axis=-1).astype(v.dtype)
        return jnp.einsum('bhgqk,bkhd->bqhgd', p, v)

    o = lax.map(one_block, qb)
    return jnp.moveaxis(o, 0, 1).reshape(B, T, Hkv * G * dh)


def token_mixing(x, mem, w_in, mlstm_gate_bias, mlstm_conv_w, mlstm_conv_b, mlstm_norm_g,
                 attn_q_norm_g, attn_k_norm_g, w_mem_kv, w_branch_mlstm, w_branch_attn,
                 w_branch_mem, w_out):
    B, T, _ = x.shape
    proj = x @ w_in
    q_m, k_m, v_m, o_m, g_m, q_a, k_a, v_a, q_c, g_br = split_cols(proj, IN_SPLITS)

    qk_m = jax.nn.silu(dwconv_centred(jnp.concatenate([q_m, k_m], axis=-1), mlstm_conv_w, mlstm_conv_b))
    heads_m = lambda a: a.reshape(B, T, MLSTM_HEADS, MLSTM_DH).astype(jnp.float32)
    h_m = bidirectional_mlstm(heads_m(qk_m[..., :MLSTM_W]), heads_m(qk_m[..., MLSTM_W:]), heads_m(v_m),
                              (g_m + mlstm_gate_bias).astype(jnp.float32))
    h_m = head_layer_norm(h_m, mlstm_norm_g).astype(x.dtype) * jax.nn.sigmoid(o_m)

    ang_r, ang_c = axial_rope_angles(T)
    qa = apply_axial_rope(rms_norm(q_a.reshape(B, T, ATTN_HEADS, ATTN_DH), attn_q_norm_g), ang_r, ang_c)
    ka = apply_axial_rope(rms_norm(k_a.reshape(B, T, KV_HEADS, ATTN_DH), attn_k_norm_g), ang_r, ang_c)
    h_a = blocked_attention(qa.reshape(B, T, KV_HEADS, ATTN_GROUP, ATTN_DH), ka,
                            v_a.reshape(B, T, KV_HEADS, ATTN_DH))

    M = mem.shape[1]
    kv_c = mem @ w_mem_kv
    k_c = kv_c[..., :MEM_W].reshape(B, M, MEM_HEADS, MEM_DH)
    v_c = kv_c[..., MEM_W:].reshape(B, M, MEM_HEADS, MEM_DH)
    s_c = jnp.einsum('bthd,bmhd->bhtm', q_c.reshape(B, T, MEM_HEADS, MEM_DH), k_c).astype(jnp.float32) * (MEM_DH ** -0.5)
    p_c = jax.nn.softmax(s_c, axis=-1).astype(v_c.dtype)
    h_c = jnp.einsum('bhtm,bmhd->bthd', p_c, v_c).reshape(B, T, MEM_W)

    gates = jax.nn.sigmoid(g_br.reshape(B, T, N_BRANCH, D_MODEL))
    merged = (gates[:, :, 0] * (h_m @ w_branch_mlstm)
              + gates[:, :, 1] * (h_a @ w_branch_attn)
              + gates[:, :, 2] * (h_c @ w_branch_mem))
    return merged @ w_out


def conv_ffn(x, w_ffn_up, ffn_conv_w, ffn_conv_b, w_ffn_down):
    u = dwconv_centred(x @ w_ffn_up, ffn_conv_w, ffn_conv_b)
    return (jax.nn.gelu(u[..., :D_FF]) * u[..., D_FF:]) @ w_ffn_down


def encoder_trunk(x, mem, ln_in_g, ln_in_b, w_in, mlstm_gate_bias, mlstm_conv_w, mlstm_conv_b,
                  mlstm_norm_g, attn_q_norm_g, attn_k_norm_g, w_mem_kv, w_branch_mlstm,
                  w_branch_attn, w_branch_mem, w_out, ln1_g, ln1_b, w_ffn_up, ffn_conv_w,
                  ffn_conv_b, w_ffn_down, ln2_g, ln2_b):
    x = layer_norm(x, ln_in_g, ln_in_b)
    for l in range(DEPTH):
        mixed = token_mixing(x, mem, w_in[l], mlstm_gate_bias[l], mlstm_conv_w[l], mlstm_conv_b[l],
                             mlstm_norm_g[l], attn_q_norm_g[l], attn_k_norm_g[l], w_mem_kv[l],
                             w_branch_mlstm[l], w_branch_attn[l], w_branch_mem[l], w_out[l])
        x = layer_norm(DEEPNORM_ALPHA * x + mixed, ln1_g[l], ln1_b[l])
        ff = conv_ffn(x, w_ffn_up[l], ffn_conv_w[l], ffn_conv_b[l], w_ffn_down[l])
        x = layer_norm(DEEPNORM_ALPHA * x + ff, ln2_g[l], ln2_b[l])
    return x


def setup_inputs(seed: int = 0) -> dict:
    key = jax.random.key(seed)
    ks = jax.random.split(key, 32)
    f32 = jnp.float32
    nrm = lambda i, shape, scale: jax.random.normal(ks[i], shape, f32) * scale
    fb = jnp.linspace(3.0, 6.0, MLSTM_HEADS, dtype=f32)
    zh = jnp.zeros((MLSTM_HEADS,), f32)
    gate_base = jnp.concatenate([zh, fb, zh, fb])
    return {
        "x_prompt": nrm(0, (BATCH, SEQ, D_MODEL), 1.0),
        "x_sample": nrm(1, (DEC_BATCH, DEC_SEQ, D_MODEL), 1.0),
        "mem_prompt": nrm(2, (BATCH, N_MEM, D_MODEL), 1.0),
        "mem_sample": nrm(3, (DEC_BATCH, N_MEM, D_MODEL), 1.0),
        "ln_in_g": 1.0 + nrm(4, (D_MODEL,), 0.02),
        "ln_in_b": nrm(5, (D_MODEL,), 0.02),
        "w_in": nrm(6, (DEPTH, D_MODEL, IN_W), D_MODEL ** -0.5),
        "mlstm_gate_bias": gate_base + nrm(7, (DEPTH, 4 * MLSTM_HEADS), 0.1),
        "mlstm_conv_w": nrm(8, (DEPTH, CONV_W, 2 * MLSTM_W), CONV_W ** -0.5),
        "mlstm_conv_b": nrm(9, (DEPTH, 2 * MLSTM_W), 0.02),
        "mlstm_norm_g": 1.0 + nrm(10, (DEPTH, MLSTM_W), 0.02),
        "attn_q_norm_g": 1.0 + nrm(11, (DEPTH, ATTN_DH), 0.02),
        "attn_k_norm_g": 1.0 + nrm(12, (DEPTH, ATTN_DH), 0.02),
        "w_mem_kv": nrm(13, (DEPTH, D_MODEL, 2 * MEM_W), D_MODEL ** -0.5),
        "w_branch_mlstm": nrm(14, (DEPTH, MLSTM_W, D_MODEL), MLSTM_W ** -0.5 * DEEPNORM_BETA),
        "w_branch_attn": nrm(15, (DEPTH, ATTN_W, D_MODEL), ATTN_W ** -0.5 * DEEPNORM_BETA),
        "w_branch_mem": nrm(16, (DEPTH, MEM_W, D_MODEL), MEM_W ** -0.5 * DEEPNORM_BETA),
        "w_out": nrm(17, (DEPTH, D_MODEL, D_MODEL), D_MODEL ** -0.5 * DEEPNORM_BETA),
        "ln1_g": 1.0 + nrm(18, (DEPTH, D_MODEL), 0.02),
        "ln1_b": nrm(19, (DEPTH, D_MODEL), 0.02),
        "w_ffn_up": nrm(20, (DEPTH, D_MODEL, 2 * D_FF), D_MODEL ** -0.5 * DEEPNORM_BETA),
        "ffn_conv_w": nrm(21, (DEPTH, CONV_W, 2 * D_FF), CONV_W ** -0.5),
        "ffn_conv_b": nrm(22, (DEPTH, 2 * D_FF), 0.02),
        "w_ffn_down": nrm(23, (DEPTH, D_FF, D_MODEL), D_FF ** -0.5 * DEEPNORM_BETA),
        "ln2_g": 1.0 + nrm(24, (DEPTH, D_MODEL), 0.02),
        "ln2_b": nrm(25, (DEPTH, D_MODEL), 0.02),
    }


def reference(x_prompt, x_sample, mem_prompt, mem_sample, ln_in_g, ln_in_b, w_in, mlstm_gate_bias,
              mlstm_conv_w, mlstm_conv_b, mlstm_norm_g, attn_q_norm_g, attn_k_norm_g, w_mem_kv,
              w_branch_mlstm, w_branch_attn, w_branch_mem, w_out, ln1_g, ln1_b, w_ffn_up,
              ffn_conv_w, ffn_conv_b, w_ffn_down, ln2_g, ln2_b):
    weights = (ln_in_g, ln_in_b, w_in, mlstm_gate_bias, mlstm_conv_w, mlstm_conv_b, mlstm_norm_g,
               attn_q_norm_g, attn_k_norm_g, w_mem_kv, w_branch_mlstm, w_branch_attn, w_branch_mem,
               w_out, ln1_g, ln1_b, w_ffn_up, ffn_conv_w, ffn_conv_b, w_ffn_down, ln2_g, ln2_b)
    y_prompt = encoder_trunk(x_prompt, mem_prompt, *weights)
    y_sample = encoder_trunk(x_sample, mem_sample, *weights)
    return (y_prompt, y_sample)
```

```cpp
#include <hip/hip_runtime.h>
#include <hip/hip_cooperative_groups.h>
#include <cstdio>
#include <cstdint>
namespace cg = cooperative_groups;
#define ENABLE_MIX 1
#define MIX_MLSTM 1
#define MIX_GQA 1
namespace pg8 {
#define PG8_LAS __attribute__((address_space(3)))
typedef unsigned short bf16_t;
typedef short bf16x8 __attribute__((ext_vector_type(8)));
typedef float f32x4 __attribute__((ext_vector_type(4)));
typedef unsigned u32x4 __attribute__((ext_vector_type(4)));
constexpr int BM = 256, BK = 64, HALF = 128, HTB = HALF * BK * 2  , STAGE_BYTES = 8 * HTB, NXCD = 8, WGM = 8;

__host__ __device__ __forceinline__ int lds_byte(int r, int c) { const int st = (r >> 4) * 2 + (c >> 5), rr = r & 15, cc = c & 31, ob = rr * 64 + cc * 2; return st * 1024 + (ob ^ (((ob >> 9) & 1) << 5)); }
__host__ __device__ __forceinline__ void stage_rc(int b, int& R, int& C) { const int st = b / 1024, sb = b % 1024, swz = sb ^ (((sb >> 9) & 1) << 5); R = (st >> 1) * 16 + swz / 64; C = (st & 1) * 32 + (swz % 64) / 2; }
__host__ __device__ __forceinline__ int perm32(int rho) { const int n = rho >> 4, i = rho & 15; return 8 * (i >> 2) + 4 * n + (i & 3); }

struct Unit { int pm, pn; };
struct Gemm { const bf16_t* A; const bf16_t* Bt; int M, N, K; };

struct StaticOrder {
    int nM, nN, nwg, G, c;
    __host__ __device__ void init(int M, int N, int G_, int c_) { nM = M / BM; nN = N / BM; nwg = nM * nN; G = G_; c = c_; }
    __host__ __device__ bool next(int i, Unit& u) const {
        const long L = (long)i * G + c; if (L >= nwg) return false;
        int wgid = (int)L; { const int q = nwg / NXCD, r = nwg % NXCD, xcd = wgid % NXCD, off = wgid / NXCD; wgid = (xcd < r ? xcd * (q + 1) : r * (q + 1) + (xcd - r) * q) + off; }
        const int nig = WGM * nN, gid = wgid / nig, fm = gid * WGM, gsz = (nM - fm) < WGM ? (nM - fm) : WGM;
        u.pm = fm + ((wgid % nig) % gsz); u.pn = (wgid % nig) / gsz; return true;
    }
    __device__ __forceinline__ void a_ready(const Unit&) const {}
    __device__ __forceinline__ void done(const Unit&) const {}
};

__device__ __forceinline__ unsigned cvt_pk_bf16(float lo, float hi) { unsigned r; asm volatile("v_cvt_pk_bf16_f32 %0, %1, %2" : "=v"(r) : "v"(lo), "v"(hi)); return r; }
typedef float f32x2 __attribute__((ext_vector_type(2)));
__device__ __forceinline__ f32x2 gelu_pk(f32x2 v) {
    const f32x2 av = __builtin_elementwise_abs(v), d = av * 0.2316418882f + 1.0f;
    f32x2 t; t.x = __builtin_amdgcn_rcpf(d.x); t.y = __builtin_amdgcn_rcpf(d.y);
    f32x2 q = t * 0.5307027145f + (-0.7265760135f); q = q * t + 0.7107068705f; q = q * t + (-0.142248368f); q = q * t + 0.127414796f; q = q * t;
    const f32x2 s = (v * v) * (-0.72134752044f);
    f32x2 e; e.x = __builtin_amdgcn_exp2f(s.x); e.y = __builtin_amdgcn_exp2f(s.y);
    const f32x2 m = v * (q * e), r = v - m;
    f32x2 o; o.x = v.x < 0.f ? m.x : r.x; o.y = v.y < 0.f ? m.y : r.y; return o;
}

#define PG8_GAS __attribute__((address_space(1)))
__device__ __forceinline__ float sigm(float x) { return __builtin_amdgcn_rcpf(1.0f + __expf(-x)); }
__device__ __forceinline__ void st8_bf16(bf16_t* p, const f32x4 v0, const f32x4 v1) {
    u32x4 w; w.x = cvt_pk_bf16(v0[0], v0[1]); w.y = cvt_pk_bf16(v0[2], v0[3]); w.z = cvt_pk_bf16(v1[0], v1[1]); w.w = cvt_pk_bf16(v1[2], v1[3]);
    *(PG8_GAS u32x4*)p = w;
}
__device__ __forceinline__ void ld8_bf16(const bf16_t* p, f32x4& v0, f32x4& v1) {
    const u32x4 w = *(const PG8_GAS u32x4*)p;
    v0[0] = __uint_as_float(w.x << 16); v0[1] = __uint_as_float(w.x & 0xffff0000u); v0[2] = __uint_as_float(w.y << 16); v0[3] = __uint_as_float(w.y & 0xffff0000u);
    v1[0] = __uint_as_float(w.z << 16); v1[1] = __uint_as_float(w.z & 0xffff0000u); v1[2] = __uint_as_float(w.w << 16); v1[3] = __uint_as_float(w.w & 0xffff0000u);
}
struct EpiInProj {
    static constexpr bool PERM = true, AFTER_DRAIN = false;
    bf16_t *QKM, *VM, *OM, *QA, *KA, *VA, *QC, *GBR;
    __device__ __forceinline__ void operator()(const f32x4 (&acc)[2][2][4][2], const Unit& u, int wr, int wc, int fr, int fq) const {
        const int pn = u.pn; bf16_t* base; int ld, cb; bool act = false;
        if (pn < 4) { base = QKM; ld = 1024; cb = 256 * pn; }
        else if (pn < 6) { base = VM; ld = 512; cb = 256 * (pn - 4); }
        else if (pn < 8) { base = OM; ld = 512; cb = 256 * (pn - 6); act = true; }
        else if (pn < 12) { base = QA; ld = 1024; cb = 256 * (pn - 8); }
        else if (pn == 12) { base = KA; ld = 256; cb = 0; }
        else if (pn == 13) { base = VA; ld = 256; cb = 0; }
        else if (pn < 16) { base = QC; ld = 512; cb = 256 * (pn - 14); }
        else { base = GBR; ld = 3072; cb = 256 * (pn - 16); act = true; }
        const int row0 = u.pm * BM + wr * 64 + fr, col0 = cb + wc * 32 + 8 * fq;
#pragma unroll
        for (int ai = 0; ai < 2; ++ai)
#pragma unroll
            for (int m = 0; m < 4; ++m) { bf16_t* rowp = base + (size_t)(row0 + ai * HALF + m * 16) * ld + col0;
#pragma unroll
                for (int bj = 0; bj < 2; ++bj) { f32x4 v0 = acc[ai][bj][m][0], v1 = acc[ai][bj][m][1];
                    if (act) {
#pragma unroll
                        for (int e = 0; e < 4; ++e) { v0[e] = sigm(v0[e]); v1[e] = sigm(v1[e]); } }
                    st8_bf16(rowp + bj * HALF, v0, v1); } }
    }
};
struct EpiSplit {
    static constexpr bool PERM = true, AFTER_DRAIN = false;
    bf16_t* O; int ld, split; size_t stride;
    __device__ __forceinline__ void operator()(const f32x4 (&acc)[2][2][4][2], const Unit& u, int wr, int wc, int fr, int fq) const {
        int colt = u.pn * BM; const int t = colt / split; colt -= t * split; bf16_t* base = O + (size_t)t * stride;
        const int row0 = u.pm * BM + wr * 64 + fr, col0 = colt + wc * 32 + 8 * fq;
#pragma unroll
        for (int ai = 0; ai < 2; ++ai)
#pragma unroll
            for (int m = 0; m < 4; ++m) { bf16_t* rowp = base + (size_t)(row0 + ai * HALF + m * 16) * ld + col0;
#pragma unroll
                for (int bj = 0; bj < 2; ++bj) st8_bf16(rowp + bj * HALF, acc[ai][bj][m][0], acc[ai][bj][m][1]); }
    }
};
struct EpiUp {
    static constexpr bool PERM = true, AFTER_DRAIN = false;
    bf16_t *U1, *U2; int ld;
    __device__ __forceinline__ void operator()(const f32x4 (&acc)[2][2][4][2], const Unit& u, int wr, int wc, int fr, int fq) const {
        const int row0 = u.pm * BM + wr * 64 + fr, col0 = u.pn * HALF + wc * 32 + 8 * fq;
#pragma unroll
        for (int ai = 0; ai < 2; ++ai)
#pragma unroll
            for (int m = 0; m < 4; ++m) { const size_t off = (size_t)(row0 + ai * HALF + m * 16) * ld + col0;
                st8_bf16(U1 + off, acc[ai][0][m][0], acc[ai][0][m][1]); st8_bf16(U2 + off, acc[ai][1][m][0], acc[ai][1][m][1]); }
    }
};
struct EpiResF32 {
    static constexpr bool PERM = true, AFTER_DRAIN = false;
    float* out; int ld; float alpha;
    __device__ __forceinline__ void operator()(const f32x4 (&acc)[2][2][4][2], const Unit& u, int wr, int wc, int fr, int fq) const {
        const int row0 = u.pm * BM + wr * 64 + fr, col0 = u.pn * BM + wc * 32 + 8 * fq;
#pragma unroll
        for (int ai = 0; ai < 2; ++ai)
#pragma unroll
            for (int m = 0; m < 4; ++m) { float* rowp = out + (size_t)(row0 + ai * HALF + m * 16) * ld + col0;
#pragma unroll
                for (int bj = 0; bj < 2; ++bj) { PG8_GAS f32x4* p = (PG8_GAS f32x4*)(rowp + bj * HALF);
                    const f32x4 a0 = p[0], a1 = p[1]; p[0] = a0 * alpha + acc[ai][bj][m][0]; p[1] = a1 * alpha + acc[ai][bj][m][1]; } }
    }
};
struct EpiWout {
    static constexpr bool PERM = true, AFTER_DRAIN = false;
    const float* x; const float* stats; const float* g; const float* b; float* out; float alpha;
    __device__ __forceinline__ void operator()(const f32x4 (&acc)[2][2][4][2], const Unit& u, int wr, int wc, int fr, int fq) const {
        const int row0 = u.pm * BM + wr * 64 + fr, col0 = u.pn * BM + wc * 32 + 8 * fq;
        f32x4 gv[2][2], bv[2][2];
#pragma unroll
        for (int bj = 0; bj < 2; ++bj)
#pragma unroll
            for (int n = 0; n < 2; ++n) { gv[bj][n] = *(const PG8_GAS f32x4*)(g + col0 + bj * HALF + 4 * n); bv[bj][n] = *(const PG8_GAS f32x4*)(b + col0 + bj * HALF + 4 * n); }
#pragma unroll
        for (int ai = 0; ai < 2; ++ai)
#pragma unroll
            for (int m = 0; m < 4; ++m) { const int row = row0 + ai * HALF + m * 16; const size_t off = (size_t)row * 1024 + col0;
                const float mu = stats[2 * row], rs = stats[2 * row + 1];
#pragma unroll
                for (int bj = 0; bj < 2; ++bj)
#pragma unroll
                    for (int n = 0; n < 2; ++n) { const f32x4 xv = *(const PG8_GAS f32x4*)(x + off + bj * HALF + 4 * n);
                        const f32x4 xn = (xv - mu) * rs * gv[bj][n] + bv[bj][n];
                        *(PG8_GAS f32x4*)(out + off + bj * HALF + 4 * n) = xn * alpha + acc[ai][bj][m][n]; } }
    }
};
template <int MODE> struct EpiMerge {
    static constexpr bool PERM = true, AFTER_DRAIN = false;
    const bf16_t* GBR; int goff; float* S; bf16_t* MERGED;
    __device__ __forceinline__ void operator()(const f32x4 (&acc)[2][2][4][2], const Unit& u, int wr, int wc, int fr, int fq) const {
        const int row0 = u.pm * BM + wr * 64 + fr, col0 = u.pn * BM + wc * 32 + 8 * fq;
#pragma unroll
        for (int ai = 0; ai < 2; ++ai)
#pragma unroll
            for (int m = 0; m < 4; ++m) { const int row = row0 + ai * HALF + m * 16;
#pragma unroll
                for (int bj = 0; bj < 2; ++bj) { const int c = col0 + bj * HALF; f32x4 g0, g1; ld8_bf16(GBR + (size_t)row * 3072 + goff + c, g0, g1);
                    f32x4 v0 = g0 * acc[ai][bj][m][0], v1 = g1 * acc[ai][bj][m][1];
                    PG8_GAS f32x4* sp = (PG8_GAS f32x4*)(S + (size_t)row * 1024 + c);
                    if (MODE == 1 || MODE == 2) { v0 += sp[0]; v1 += sp[1]; }
                    if (MODE <= 1) { sp[0] = v0; sp[1] = v1; } else st8_bf16(MERGED + (size_t)row * 1024 + c, v0, v1); } }
    }
};
template <class Epi, class Sched, bool ALIGN_EPI = false, bool SP2 = false>
__device__ __forceinline__ void gemm_phase(PG8_LAS unsigned char* lds, const Gemm g, const Sched& S, const Epi& E) {
    int tid_ = threadIdx.x; asm volatile("" : "+v"(tid_));
    const int tid = tid_, wid = __builtin_amdgcn_readfirstlane(tid >> 6), lane = tid & 63, wr = wid >> 2, wc = wid & 3, fr = lane & 15, fq = lane >> 4;
    const int K = g.K, nt = K / BK;
    unsigned voffA[2], voffB[2];
#pragma unroll
    for (int i = 0; i < 2; ++i) { int R, C; stage_rc(tid * 16 + i * 8192, R, C); const int Rb = Epi::PERM ? ((R & ~31) + perm32(R & 31)) : R;
        voffA[i] = (unsigned)(R * K + C) * 2u; voffB[i] = (unsigned)(Rb * K + C) * 2u; }
    const size_t kstep = (size_t)(BK * 2);
    const size_t hstep = (size_t)HALF * K * 2;
    const size_t tstep = 2 * hstep;
    const unsigned ldsw = (unsigned)wid * 1024u;
    const int aoff = lds_byte(wr * 64 + fr, fq * 8), boff = lds_byte(wc * 32 + fr, fq * 8);
#define PG8_SA(b, h) (((b) * 2 + (h)) * HTB)
#define PG8_SB(b, h) ((4 + (b) * 2 + (h)) * HTB)
#define PG8_STAGE(bufoff, gbase, voff) do { _Pragma("unroll") for (int _i = 0; _i < 2; ++_i) \
        __builtin_amdgcn_global_load_lds((const unsigned*)((const char*)(gbase) + (voff)[_i]), (PG8_LAS unsigned*)(lds + (bufoff) + ldsw + _i * 8192), 16, 0, 0); } while (0)
#define PG8_LDA(dst, b, h) do { _Pragma("unroll") for (int m = 0; m < 4; ++m) _Pragma("unroll") for (int k = 0; k < 2; ++k) dst[m][k] = *(const PG8_LAS bf16x8*)(lds + PG8_SA(b, h) + aoff + m * 2048 + k * 1024); } while (0)
#define PG8_LDB(dst, b, h) do { _Pragma("unroll") for (int n = 0; n < 2; ++n) _Pragma("unroll") for (int k = 0; k < 2; ++k) dst[n][k] = *(const PG8_LAS bf16x8*)(lds + PG8_SB(b, h) + boff + n * 2048 + k * 1024); } while (0)
#define PG8_MMA(ai, bj, At, Bt) do { __builtin_amdgcn_s_setprio(1); _Pragma("unroll") for (int m = 0; m < 4; ++m) _Pragma("unroll") for (int n = 0; n < 2; ++n) _Pragma("unroll") for (int k = 0; k < 2; ++k) \
        acc[ai][bj][m][n] = __builtin_amdgcn_mfma_f32_16x16x32_bf16(Bt[n][k], At[m][k], acc[ai][bj][m][n], 0, 0, 0); __builtin_amdgcn_s_setprio(0); } while (0)
#define PG8_WAIT_V(n) asm volatile("s_waitcnt vmcnt(" #n ")" ::: "memory")
#define PG8_WAIT_L(n) asm volatile("s_waitcnt lgkmcnt(" #n ")" ::: "memory")
#define PG8_BAR __builtin_amdgcn_s_barrier()
#define PG8_SCHED __builtin_amdgcn_sched_barrier(0)
    Unit cur, nxt; int ui = 0;
    if (!S.next(0, cur)) return;
    f32x4 acc[2][2][4][2];
#pragma unroll
    for (int a = 0; a < 2; ++a)
#pragma unroll
        for (int b = 0; b < 2; ++b)
#pragma unroll
            for (int m = 0; m < 4; ++m)
#pragma unroll
                for (int n = 0; n < 2; ++n) acc[a][b][m][n] = (f32x4){0.f, 0.f, 0.f, 0.f};
    bf16x8 At[4][2], B0[2][2], B1[2][2];
    const char* cA = (const char*)g.A + (size_t)cur.pm * tstep; const char* cB = (const char*)g.Bt + (size_t)cur.pn * tstep;
    S.a_ready(cur);
    if constexpr (SP2) {
        PG8_STAGE(PG8_SB(0, 0), cB, voffB); PG8_STAGE(PG8_SB(0, 1), cB + hstep, voffB); PG8_STAGE(PG8_SA(0, 0), cA, voffA); PG8_STAGE(PG8_SA(0, 1), cA + hstep, voffA);
        if (wr == 1) PG8_BAR;
        PG8_WAIT_V(2); PG8_BAR;
        PG8_STAGE(PG8_SB(1, 0), cB + kstep, voffB); PG8_STAGE(PG8_SA(1, 0), cA + kstep, voffA); PG8_STAGE(PG8_SB(1, 1), cB + hstep + kstep, voffB);
        PG8_WAIT_V(6); PG8_BAR;
    } else {
        PG8_STAGE(PG8_SB(0, 0), cB, voffB); PG8_STAGE(PG8_SA(0, 0), cA, voffA); PG8_STAGE(PG8_SB(0, 1), cB + hstep, voffB); PG8_STAGE(PG8_SA(0, 1), cA + hstep, voffA);
        if (wr == 1) PG8_BAR;
        PG8_WAIT_V(4); PG8_BAR;
        PG8_STAGE(PG8_SB(1, 0), cB + kstep, voffB); PG8_STAGE(PG8_SA(1, 0), cA + kstep, voffA); PG8_STAGE(PG8_SB(1, 1), cB + hstep + kstep, voffB);
        PG8_WAIT_V(6); PG8_BAR;
    }
    for (;;) {
        const bool has_next = S.next(ui + 1, nxt);
        const char* nA = has_next ? (const char*)g.A + (size_t)nxt.pm * tstep : cA; const char* nB = has_next ? (const char*)g.Bt + (size_t)nxt.pn * tstep : cB;
        for (int t = 0; t < nt; t += 2) {
            const bool last = (t == nt - 2);
            const char* a1 = cA + (size_t)(t + 1) * kstep;
            const char* a2 = last ? nA : cA + (size_t)(t + 2) * kstep; const char* b2 = last ? nB : cB + (size_t)(t + 2) * kstep;
            const char* a3 = a2 + kstep; const char* b3 = b2 + kstep;
            if (last && has_next) S.a_ready(nxt);
            if constexpr (SP2) {
            PG8_LDB(B0, 0, 0); PG8_LDB(B1, 0, 1); PG8_SCHED; PG8_LDA(At, 0, 0); PG8_STAGE(PG8_SA(1, 1), a1 + hstep, voffA);
            PG8_WAIT_V(8); PG8_WAIT_L(0); PG8_BAR; PG8_MMA(0, 0, At, B0); PG8_MMA(0, 1, At, B1); PG8_BAR; PG8_SCHED;
            PG8_LDA(At, 0, 1); PG8_STAGE(PG8_SB(0, 0), b2, voffB); PG8_STAGE(PG8_SB(0, 1), b2 + hstep, voffB); PG8_STAGE(PG8_SA(0, 0), a2, voffA);
            PG8_WAIT_V(8); PG8_WAIT_L(0); PG8_BAR; PG8_MMA(1, 0, At, B0); PG8_MMA(1, 1, At, B1); PG8_BAR; PG8_SCHED;
            PG8_LDB(B0, 1, 0); PG8_LDB(B1, 1, 1); PG8_SCHED; PG8_LDA(At, 1, 0); PG8_STAGE(PG8_SA(0, 1), a2 + hstep, voffA);
            PG8_WAIT_V(8); PG8_WAIT_L(0); PG8_BAR; PG8_MMA(0, 0, At, B0); PG8_MMA(0, 1, At, B1); PG8_BAR; PG8_SCHED;
            PG8_LDA(At, 1, 1); PG8_STAGE(PG8_SB(1, 0), b3, voffB); PG8_STAGE(PG8_SB(1, 1), b3 + hstep, voffB); PG8_STAGE(PG8_SA(1, 0), a3, voffA);
            PG8_WAIT_V(8); PG8_WAIT_L(0); PG8_BAR; PG8_MMA(1, 0, At, B0); PG8_MMA(1, 1, At, B1); PG8_BAR; PG8_SCHED;
            } else {
            PG8_LDB(B0, 0, 0); PG8_SCHED; PG8_LDA(At, 0, 0); PG8_STAGE(PG8_SA(1, 1), a1 + hstep, voffA);
            PG8_WAIT_L(8); PG8_BAR; PG8_WAIT_L(0); PG8_MMA(0, 0, At, B0); PG8_BAR; PG8_SCHED;
            PG8_LDB(B1, 0, 1); PG8_STAGE(PG8_SB(0, 0), b2, voffB);
            PG8_BAR; PG8_WAIT_L(0); PG8_MMA(0, 1, At, B1); PG8_BAR;
            PG8_LDA(At, 0, 1); PG8_STAGE(PG8_SA(0, 0), a2, voffA);
            PG8_BAR; PG8_WAIT_L(0); PG8_MMA(1, 0, At, B0); PG8_BAR; PG8_SCHED;
            PG8_STAGE(PG8_SB(0, 1), b2 + hstep, voffB);
            PG8_WAIT_V(6); PG8_BAR; PG8_MMA(1, 1, At, B1); PG8_BAR;
            PG8_LDB(B0, 1, 0); PG8_SCHED; PG8_LDA(At, 1, 0); PG8_STAGE(PG8_SA(0, 1), a2 + hstep, voffA);
            PG8_WAIT_L(8); PG8_BAR; PG8_WAIT_L(0); PG8_MMA(0, 0, At, B0); PG8_BAR; PG8_SCHED;
            PG8_LDB(B1, 1, 1); PG8_STAGE(PG8_SB(1, 0), b3, voffB);
            PG8_BAR; PG8_WAIT_L(0); PG8_MMA(0, 1, At, B1); PG8_BAR;
            PG8_LDA(At, 1, 1); PG8_STAGE(PG8_SA(1, 0), a3, voffA);
            PG8_BAR; PG8_WAIT_L(0); PG8_MMA(1, 0, At, B0); PG8_BAR; PG8_SCHED;
            PG8_STAGE(PG8_SB(1, 1), b3 + hstep, voffB);
            PG8_WAIT_V(6); PG8_BAR; PG8_MMA(1, 1, At, B1); PG8_BAR;
            }
        }
        if constexpr (ALIGN_EPI) { if (wr == 0) PG8_BAR; }
        if constexpr (!Epi::AFTER_DRAIN) { E(acc, cur, wr, wc, fr, fq); S.done(cur); }
        if (!has_next) break;
#pragma unroll
        for (int a = 0; a < 2; ++a)
#pragma unroll
            for (int b = 0; b < 2; ++b)
#pragma unroll
                for (int m = 0; m < 4; ++m)
#pragma unroll
                    for (int n = 0; n < 2; ++n) acc[a][b][m][n] = (f32x4){0.f, 0.f, 0.f, 0.f};
        cur = nxt; cA = nA; cB = nB; ++ui;
        if constexpr (ALIGN_EPI) { if (wr == 1) PG8_BAR; }
    }
    PG8_WAIT_V(0);
    if constexpr (!ALIGN_EPI) { if (wr == 0) PG8_BAR; }
    PG8_BAR;
    if constexpr (Epi::AFTER_DRAIN) { E.fused(acc, cur, wr, wc, fr, fq, lds, wid, lane); S.done(cur); }
#undef PG8_SA
#undef PG8_SB
#undef PG8_STAGE
#undef PG8_LDA
#undef PG8_LDB
#undef PG8_MMA
#undef PG8_WAIT_V
#undef PG8_WAIT_L
#undef PG8_BAR
#undef PG8_SCHED
}
}
#define LAS __attribute__((address_space(3)))
#define GAS __attribute__((address_space(1)))
typedef unsigned short bf16_t;
typedef unsigned v4u __attribute__((ext_vector_type(4)));
typedef unsigned v2u __attribute__((ext_vector_type(2)));
typedef float f32x4 __attribute__((ext_vector_type(4)));
typedef short bf16x8 __attribute__((ext_vector_type(8)));
constexpr int NWAVES = 8, NTHR = 512;
constexpr int DM = 1024, SEQ = 2048, NGRP = 3, BG = 8, MG = BG * SEQ;
constexpr int INW = 7184, NIN = 7168, DFF = 2816, NUP = 2 * DFF, NMEM = 256, MEMR = BG * NMEM;
constexpr float ALPHA = 1.18920711500272f, LN_EPS = 1e-5f;
constexpr size_t MiB = 1u << 20;
constexpr size_t WS_WIN = 1 * MiB, WS_WG = 15 * MiB, WS_WMEM = 16 * MiB, WS_WBM = 18 * MiB, WS_WBA = 19 * MiB, WS_WBC = 21 * MiB, WS_WOUT = 22 * MiB, WS_WUP = 24 * MiB, WS_WDN = 35 * MiB;
constexpr size_t WS_MEMB = 41 * MiB, WS_STATS = 53 * MiB, WS_XN = 54 * MiB;
constexpr size_t WS_QKM = 86 * MiB, WS_VM = 118 * MiB, WS_OM = 134 * MiB, WS_QA = 150 * MiB, WS_KA = 182 * MiB, WS_VA = 190 * MiB, WS_QC = 198 * MiB, WS_GBR = 214 * MiB, WS_GT = 310 * MiB;
constexpr size_t WS_KC = 311 * MiB, WS_VC = 313 * MiB, WS_CT = 315 * MiB, WS_NP = 347 * MiB, WS_MERGED = 348 * MiB, WS_SCR = 380 * MiB, WS_END = 444 * MiB;
constexpr size_t WS_U1 = 86 * MiB, WS_U2 = 174 * MiB, WS_HID = 262 * MiB;
constexpr int LDS_BYTES = 147456, RING_BYTES = 131072;
struct Args { const float* in[26]; float* out; unsigned char* ws; };

__device__ __forceinline__ float wave_sum(float v) {
#pragma unroll
    for (int o = 1; o < 64; o <<= 1) v += __shfl_xor(v, o);
    return v;
}
__device__ __forceinline__ unsigned pk2(float lo, float hi) { return pg8::cvt_pk_bf16(lo, hi); }
__device__ __forceinline__ float bflo(unsigned w) { return __uint_as_float(w << 16); }
__device__ __forceinline__ float bfhi(unsigned w) { return __uint_as_float(w & 0xffff0000u); }
#define LDS_WAIT() asm volatile("s_waitcnt lgkmcnt(0)" ::: "memory")

__device__ __forceinline__ void transpose_item(const float* W, int Nsrc, int K, bf16_t* WT, int k0, int n0dst, int n0src, LAS float* scr, int lane) {
#pragma unroll 8
    for (int i = 0; i < 32; ++i) { const int kk = 2 * i + (lane >> 5); scr[kk * 33 + (lane & 31)] = ((const GAS float*)W)[(size_t)(k0 + kk) * Nsrc + n0src + (lane & 31)]; }
    LDS_WAIT(); asm volatile("" ::: "memory");
    const int c = lane & 7;
#pragma unroll
    for (int j = 0; j < 4; ++j) { const int n = (lane >> 3) + 8 * j; const LAS float* s = scr + (8 * c) * 33 + n;
        v4u o; o.x = pk2(s[0 * 33], s[1 * 33]); o.y = pk2(s[2 * 33], s[3 * 33]); o.z = pk2(s[4 * 33], s[5 * 33]); o.w = pk2(s[6 * 33], s[7 * 33]);
        *(GAS v4u*)(WT + (size_t)(n0dst + n) * K + k0 + 8 * c) = o; }
    LDS_WAIT(); asm volatile("" ::: "memory");
}
__device__ __forceinline__ void ln_row(const float* src, const float* g, const float* b, float* of32, bf16_t* obf, float* stats, int lane) {
    const GAS f32x4* xr = (const GAS f32x4*)src + lane;
    f32x4 v[4]; float s = 0.f;
#pragma unroll
    for (int j = 0; j < 4; ++j) { v[j] = xr[64 * j]; s += (v[j].x + v[j].y) + (v[j].z + v[j].w); }
    const float mean = wave_sum(s) * (1.f / DM); float s2 = 0.f;
#pragma unroll
    for (int j = 0; j < 4; ++j) { v[j] = v[j] - mean; s2 += (v[j].x * v[j].x + v[j].y * v[j].y) + (v[j].z * v[j].z + v[j].w * v[j].w); }
    const float rstd = 1.f / sqrtf(wave_sum(s2) * (1.f / DM) + LN_EPS);
    if (stats && lane == 0) { stats[0] = mean; stats[1] = rstd; }
#pragma unroll
    for (int j = 0; j < 4; ++j) { const f32x4 gv = ((const GAS f32x4*)g)[lane + 64 * j], bv = ((const GAS f32x4*)b)[lane + 64 * j];
        const f32x4 o = v[j] * rstd * gv + bv;
        if (of32) ((GAS f32x4*)of32)[lane + 64 * j] = o;
        if (obf) { v2u w; w.x = pk2(o.x, o.y); w.y = pk2(o.z, o.w); ((GAS v2u*)obf)[lane + 64 * j] = w; } }
}
__device__ __forceinline__ float gelu_tanh(float x) {
    const float u = 0.7978845608028654f * (x + 0.044715f * x * x * x);
    const float e = __expf(2.f * u);
    const float th = 1.f - 2.f * __builtin_amdgcn_rcpf(e + 1.f);
    return 0.5f * x * (1.f + th);
}
namespace att {
using bf16 = unsigned short;
constexpr int   D = 128, NW = 8, QBLK = 32, KVBLK = 64;
constexpr float SCALE = 0.088388347648318440f;
constexpr float THR = 8.f;
constexpr int SDEPTH = 2;
constexpr size_t SHM_V = KVBLK * D * 2, SHM_K = KVBLK * D * 2, SHM_ATTN = 2 * SHM_V + 2 * SHM_K + NW * 64 * 4;
using bf16x8 = __attribute__((ext_vector_type(8))) short;
using s16x4  = __attribute__((ext_vector_type(4))) short;
using f32x16 = __attribute__((ext_vector_type(16))) float;
using f32x8  = __attribute__((ext_vector_type(8))) float;
using u32x4  = __attribute__((ext_vector_type(4))) unsigned;
#define KSWZ(row, colB) ((row) * 256 + ((colB) ^ (((row) & 7) << 4)))
#define SBAR() __builtin_amdgcn_sched_barrier(0)
__device__ __forceinline__ int crow(int r, int hi) { return (r & 3) + 8 * (r >> 2) + 4 * hi; }
__device__ __forceinline__ unsigned cvtpk(float lo, float hi) {
  unsigned r; asm volatile("v_cvt_pk_bf16_f32 %0, %1, %2" : "=v"(r) : "v"(lo), "v"(hi)); return r;
}
template <typename TIn> struct Stage;
template <> struct Stage<bf16>  { using T = bf16x8;
  __device__ static __forceinline__ T ld8(const bf16* p) { return *reinterpret_cast<const bf16x8*>(p); }
  __device__ static __forceinline__ bf16x8 tobf(T x) { return x; } };
template <> struct Stage<float> { using T = f32x8;
  __device__ static __forceinline__ T ld8(const float* p) { return *reinterpret_cast<const f32x8*>(p); }
  __device__ static __forceinline__ bf16x8 tobf(T x) {
    u32x4 w = {cvtpk(x[0], x[1]), cvtpk(x[2], x[3]), cvtpk(x[4], x[5]), cvtpk(x[6], x[7])}; return *reinterpret_cast<bf16x8*>(&w); } };

__device__ __forceinline__ void partialSM(f32x16& p0, f32x16& p1, float& m_reg, float& mn, float& alpha) {
  constexpr float C = SCALE * 1.4426950408889634f;
  float pmax = p0[0]; for (int r = 1; r < 16; ++r) pmax = fmaxf(pmax, p0[r]); for (int r = 0; r < 16; ++r) pmax = fmaxf(pmax, p1[r]);
  { auto rr = __builtin_amdgcn_permlane32_swap(__float_as_uint(pmax), __float_as_uint(pmax), false, false);
    pmax = fmaxf(__uint_as_float(rr[0]), __uint_as_float(rr[1])); }
  if (__builtin_expect(__all(pmax - m_reg <= THR / SCALE), 1)) { mn = m_reg; alpha = 1.f; }
  else { mn = fmaxf(m_reg, pmax); alpha = __builtin_amdgcn_exp2f((m_reg - mn) * C); m_reg = mn; }
  float mnC = -mn * C;
  for (int r = 0; r < 16; ++r) p0[r] = fmaf(p0[r], C, mnC); for (int r = 0; r < 16; ++r) p1[r] = fmaf(p1[r], C, mnC);
  for (int r = 0; r < 16; ++r) p0[r] = __builtin_amdgcn_exp2f(p0[r]);
}
__device__ __forceinline__ void finishSM(f32x16& p0, f32x16& p1, float alpha, float& l_reg, bf16x8& pa0, bf16x8& pa1, bf16x8& pa2, bf16x8& pa3) {
  for (int r = 0; r < 16; ++r) p1[r] = __builtin_amdgcn_exp2f(p1[r]);
  float ps = 0; for (int r = 0; r < 16; ++r) ps += p0[r]; for (int r = 0; r < 16; ++r) ps += p1[r];
  { auto rr = __builtin_amdgcn_permlane32_swap(__float_as_uint(ps), __float_as_uint(ps), false, false);
    ps = __uint_as_float(rr[0]) + __uint_as_float(rr[1]); }
  l_reg = l_reg * alpha + ps;
#define PK4(P, BASE, OUT) do { unsigned a0 = cvtpk(P[BASE + 0], P[BASE + 1]), a1 = cvtpk(P[BASE + 2], P[BASE + 3]);   \
    unsigned b0 = cvtpk(P[BASE + 4], P[BASE + 5]), b1 = cvtpk(P[BASE + 6], P[BASE + 7]);                              \
    auto r0 = __builtin_amdgcn_permlane32_swap(a0, b0, false, false); auto r1 = __builtin_amdgcn_permlane32_swap(a1, b1, false, false); \
    u32x4 w = {r0[0], r1[0], r0[1], r1[1]}; OUT = *reinterpret_cast<bf16x8*>(&w); } while (0)
  PK4(p0, 0, pa0); PK4(p0, 8, pa1); PK4(p1, 0, pa2); PK4(p1, 8, pa3);
#undef PK4
}
__device__ __forceinline__ void qkt(f32x16& p0, f32x16& p1, const bf16* Ks, const bf16x8* qr, int r32, int hi) {
  p0 = f32x16{}; p1 = f32x16{};
  for (int d0 = 0; d0 < 8; ++d0) { int cb = (d0 * 16 + hi * 8) * 2;
    bf16x8 b0 = *reinterpret_cast<const bf16x8*>((const char*)Ks + KSWZ(r32, cb));
    bf16x8 b1 = *reinterpret_cast<const bf16x8*>((const char*)Ks + KSWZ(32 + r32, cb));
    p0 = __builtin_amdgcn_mfma_f32_32x32x16_bf16(b0, qr[d0], p0, 0, 0, 0);
    p1 = __builtin_amdgcn_mfma_f32_32x32x16_bf16(b1, qr[d0], p1, 0, 0, 0); }
}
__device__ __forceinline__ int v_st(int k, int c) { const int kk = (k & ~0xC) | ((k & 4) << 1) | ((k & 8) >> 1); return ((kk >> 3) * 4 + (c >> 5)) * 512 + ((kk & 7) * 32 + (c & 31)) * 2; }
__device__ __forceinline__ int v_rd_base(int lane) { return ((lane & 3) << 3) | (((lane >> 2) & 3) << 6) | (((lane >> 4) & 1) << 5) | (((lane >> 5) & 1) << 8); }
constexpr int v_rd_off(int d0, int ks, int half) { return d0 * 512 + ks * 4096 + half * 2048; }
template <int OFF> __device__ __forceinline__ s16x4 tr_read(int vb) {
  s16x4 r; asm volatile("ds_read_b64_tr_b16 %0, %1 offset:%2" : "=&v"(r) : "v"(vb), "i"(OFF) : "memory"); return r;
}
template <int D0> __device__ __forceinline__ void pv_one(f32x16& od, int vb, bf16x8 pa0, bf16x8 pa1, bf16x8 pa2, bf16x8 pa3) {
  const s16x4 l0 = tr_read<v_rd_off(D0, 0, 0)>(vb), h0 = tr_read<v_rd_off(D0, 0, 1)>(vb), l1 = tr_read<v_rd_off(D0, 1, 0)>(vb), h1 = tr_read<v_rd_off(D0, 1, 1)>(vb);
  const s16x4 l2 = tr_read<v_rd_off(D0, 2, 0)>(vb), h2 = tr_read<v_rd_off(D0, 2, 1)>(vb), l3 = tr_read<v_rd_off(D0, 3, 0)>(vb), h3 = tr_read<v_rd_off(D0, 3, 1)>(vb);
  asm volatile("s_waitcnt lgkmcnt(0)" ::: "memory"); SBAR();
#define PK(L, H) (bf16x8){L[0], L[1], L[2], L[3], H[0], H[1], H[2], H[3]}
  od = __builtin_amdgcn_mfma_f32_32x32x16_bf16(pa0, PK(l0, h0), od, 0, 0, 0);
  od = __builtin_amdgcn_mfma_f32_32x32x16_bf16(pa1, PK(l1, h1), od, 0, 0, 0);
  od = __builtin_amdgcn_mfma_f32_32x32x16_bf16(pa2, PK(l2, h2), od, 0, 0, 0);
  od = __builtin_amdgcn_mfma_f32_32x32x16_bf16(pa3, PK(l3, h3), od, 0, 0, 0);
#undef PK
}
__device__ __forceinline__ void pv_d0(f32x16* o, int vb, bf16x8 pa0, bf16x8 pa1, bf16x8 pa2, bf16x8 pa3) {
  pv_one<0>(o[0], vb, pa0, pa1, pa2, pa3); pv_one<1>(o[1], vb, pa0, pa1, pa2, pa3); pv_one<2>(o[2], vb, pa0, pa1, pa2, pa3); pv_one<3>(o[3], vb, pa0, pa1, pa2, pa3);
}

template <int LDQ, int LDK>
__device__ __forceinline__ void attn_dense_body(const bf16* Qb, const bf16* __restrict__ Kh, const bf16* __restrict__ Vh,
                                                bf16* Ob, int seq, char* lds) {
  constexpr int LDO = LDQ; using TQ = bf16; using St = Stage<bf16>; using SQ = Stage<TQ>;
  int tid_ = threadIdx.x; asm volatile("" : "+v"(tid_));
  const int tid = tid_, wid = tid >> 6, lane = tid & 63, r32 = lane & 31, hi = lane >> 5;
  bf16* V_lds = (bf16*)lds; bf16* K_lds = (bf16*)(lds + 2 * SHM_V);
  float* ws = (float*)(lds + 2 * SHM_V + 2 * SHM_K) + wid * 64; float* li_l = ws; float* al_l = ws + 32;
  float m_reg = -1e30f, l_reg = 0; f32x16 o[4] = {}; bf16x8 qr[8];
  const TQ* Qw = Qb + (long)(wid * QBLK + r32) * LDQ + hi * 8;
#pragma unroll
  for (int d0 = 0; d0 < 8; ++d0) qr[d0] = SQ::tobf(SQ::ld8(Qw + d0 * 16));
  const int sr = tid >> 4, sc = (tid & 15) * 8, vst0 = v_st(sr, sc), vst1 = v_st(32 + sr, sc);
  const int vb0 = (int)(uintptr_t)V_lds + v_rd_base(lane);
  struct { typename St::T vs0, vs1, ks0, ks1; } sr_[SDEPTH];
#define SLOAD(i, k0) do { sr_[i].vs0 = St::ld8(&Vh[(long)((k0) + sr) * LDK + sc]); sr_[i].vs1 = St::ld8(&Vh[(long)((k0) + 32 + sr) * LDK + sc]); \
    sr_[i].ks0 = St::ld8(&Kh[(long)((k0) + sr) * LDK + sc]); sr_[i].ks1 = St::ld8(&Kh[(long)((k0) + 32 + sr) * LDK + sc]); } while (0)
#define SWRITE(b, i) do { *(bf16x8*)((char*)V_lds + (b) * SHM_V + vst0) = St::tobf(sr_[i].vs0);          \
    *(bf16x8*)((char*)V_lds + (b) * SHM_V + vst1) = St::tobf(sr_[i].vs1); int kc = sc * 2;               \
    *(bf16x8*)((char*)K_lds + (b) * SHM_K + KSWZ(sr, kc)) = St::tobf(sr_[i].ks0);                       \
    *(bf16x8*)((char*)K_lds + (b) * SHM_K + KSWZ(32 + sr, kc)) = St::tobf(sr_[i].ks1); } while (0)
#define SWAIT() do { if constexpr (SDEPTH == 2) asm volatile("s_waitcnt vmcnt(4)" ::: "memory"); else asm volatile("s_waitcnt vmcnt(0)" ::: "memory"); } while (0)
#define RESC(a) do { if (__any((a) < 1.f)) { if (hi == 0) al_l[r32] = (a); asm volatile("s_waitcnt lgkmcnt(0)" ::: "memory"); \
    for (int d = 0; d < 4; ++d) for (int r = 0; r < 16; ++r) o[d][r] *= al_l[crow(r, hi)]; } } while (0)
  f32x16 pA0, pA1, pB0, pB1; float mnA, mnB, alA, alB; bf16x8 pa0, pa1, pa2, pa3; const int NT = seq / KVBLK;
  constexpr int SE = 0, SO = SDEPTH - 1;
  SLOAD(SE, 0); asm volatile("s_waitcnt vmcnt(0)" ::: "memory"); SWRITE(0, SE); __syncthreads();
  qkt(pA0, pA1, K_lds, qr, r32, hi); partialSM(pA0, pA1, m_reg, mnA, alA);
  SLOAD(SO, KVBLK); if constexpr (SDEPTH == 2) { if (2 < NT) SLOAD(SE, 2 * KVBLK); }
  SWAIT(); SWRITE(1, SO); __syncthreads();
  for (int j = 1; j + 1 < NT; j += 2) {
    SBAR(); qkt(pB0, pB1, (bf16*)((char*)K_lds + SHM_K), qr, r32, hi);
    finishSM(pA0, pA1, alA, l_reg, pa0, pa1, pa2, pa3); SBAR();
    SLOAD(SO, (j + SDEPTH) * KVBLK); SBAR();
    pv_d0(o, vb0, pa0, pa1, pa2, pa3); partialSM(pB0, pB1, m_reg, mnB, alB);
    __syncthreads(); SWAIT(); SWRITE(0, SE);
    RESC(alB); __syncthreads();
    SBAR(); qkt(pA0, pA1, K_lds, qr, r32, hi);
    finishSM(pB0, pB1, alB, l_reg, pa0, pa1, pa2, pa3); SBAR();
    if (SDEPTH == 1 || j + 3 < NT) SLOAD(SE, (j + 1 + SDEPTH) * KVBLK); SBAR();
    pv_d0(o, vb0 + (int)SHM_V, pa0, pa1, pa2, pa3); partialSM(pA0, pA1, m_reg, mnA, alA);
    __syncthreads(); SWAIT(); SWRITE(1, SO);
    RESC(alA); __syncthreads();
  }
  SBAR(); qkt(pB0, pB1, (bf16*)((char*)K_lds + SHM_K), qr, r32, hi);
  finishSM(pA0, pA1, alA, l_reg, pa0, pa1, pa2, pa3); SBAR();
  pv_d0(o, vb0, pa0, pa1, pa2, pa3); partialSM(pB0, pB1, m_reg, mnB, alB);
  __syncthreads(); RESC(alB);
  finishSM(pB0, pB1, alB, l_reg, pa0, pa1, pa2, pa3); SBAR();
  pv_d0(o, vb0 + (int)SHM_V, pa0, pa1, pa2, pa3);
  if (hi == 0) li_l[r32] = l_reg; asm volatile("s_waitcnt lgkmcnt(0)" ::: "memory");
  float rli[16];
#pragma unroll
  for (int r = 0; r < 16; ++r) rli[r] = __builtin_amdgcn_rcpf(li_l[crow(r, hi)]);
  bf16* Ow = Ob + (long)(wid * QBLK) * LDO;
#pragma unroll
  for (int r = 0; r < 16; ++r) { int orow = crow(r, hi);
    for (int d0 = 0; d0 < 4; ++d0) Ow[(long)orow * LDO + d0 * 32 + r32] = (bf16)(cvtpk(o[d0][r] * rli[r], 0.f) & 0xffffu); }
  __syncthreads();
#undef SLOAD
#undef SWRITE
#undef SWAIT
#undef RESC
}

}
namespace ml {
using att::bf16x8; using att::s16x4; using att::f32x16; using att::u32x4;
constexpr float DKS = 0.08838834764831845f;
constexpr int ML_KT = 0, ML_VT = 32768, ML_WA = 65536, ML_SM = 73728;
constexpr int M3_K = 0, M3_V = 32768, M3_CF = 65536, M3_CB = 98304, M3_X = 131072;
__device__ __forceinline__ float wscan_add(float v, int lane) {
#pragma unroll
    for (int o = 1; o < 64; o <<= 1) { const float t = __shfl_up(v, o); if (lane >= o) v += t; }
    return v; }
__device__ __forceinline__ float wscan_max(float v, int lane) {
#pragma unroll
    for (int o = 1; o < 64; o <<= 1) { const float t = __shfl_up(v, o); if (lane >= o) v = fmaxf(v, t); }
    return v; }
__device__ __forceinline__ float wrscan_max(float v, int lane) {
#pragma unroll
    for (int o = 1; o < 64; o <<= 1) { const float t = __shfl_down(v, o); if (lane + o < 64) v = fmaxf(v, t); }
    return v; }
__device__ __forceinline__ float wave_max(float v) {
#pragma unroll
    for (int o = 1; o < 64; o <<= 1) v = fmaxf(v, __shfl_xor(v, o));
    return v; }
__device__ __forceinline__ float logsig(float f) { return fminf(f, 0.f) - log1pf(expf(-fabsf(f))); }
__device__ __forceinline__ void conv_silu8(const bf16_t* p, int t, const float (&w)[3][8], const float (&b)[8], float (&o)[8]) {
    const v4u z = {0u, 0u, 0u, 0u};
    const v4u c = *(const GAS v4u*)p;
    const v4u a = (t > 0) ? *(const GAS v4u*)(p - 1024) : z;
    const v4u n = (t < SEQ - 1) ? *(const GAS v4u*)(p + 1024) : z;
#pragma unroll
    for (int q = 0; q < 4; ++q) {
        const float yl = w[0][2 * q] * bflo(a[q]) + w[1][2 * q] * bflo(c[q]) + w[2][2 * q] * bflo(n[q]) + b[2 * q];
        const float yh = w[0][2 * q + 1] * bfhi(a[q]) + w[1][2 * q + 1] * bfhi(c[q]) + w[2][2 * q + 1] * bfhi(n[q]) + b[2 * q + 1];
        o[2 * q] = yl * pg8::sigm(yl); o[2 * q + 1] = yh * pg8::sigm(yh); }
}
__device__ __forceinline__ void ld_convw(const float* cw, const float* cb, int col, float (&w)[3][8], float (&b)[8]) {
#pragma unroll
    for (int j = 0; j < 3; ++j)
#pragma unroll
        for (int e = 0; e < 8; ++e) w[j][e] = cw[j * 1024 + col + e];
#pragma unroll
    for (int e = 0; e < 8; ++e) b[e] = cb[col + e];
}
__device__ __forceinline__ bf16x8 pack8(const float (&o)[8], float s) {
    u32x4 w = {att::cvtpk(o[0] * s, o[1] * s), att::cvtpk(o[2] * s, o[3] * s), att::cvtpk(o[4] * s, o[5] * s), att::cvtpk(o[6] * s, o[7] * s)};
    return *reinterpret_cast<bf16x8*>(&w); }
#define ML_PK(L, H) (bf16x8){L[0], L[1], L[2], L[3], H[0], H[1], H[2], H[3]}

__device__ __forceinline__ void scan_item(const bf16_t* QKM, const bf16_t* VM, const float* GT, const float* cw, const float* cb, bf16_t* CT, float* NP, float* MP,
                                          int b, int h, int dir, char* lds) {
    int tid_ = threadIdx.x; asm volatile("" : "+v"(tid_));
    const int tid = tid_, wid = tid >> 6, lane = tid & 63, hi = lane >> 5;
    float* WA = (float*)(lds + ML_WA); float* SM = (float*)(lds + ML_SM);
#pragma unroll
    for (int cc = 0; cc < 2; ++cc) {
        const int c = 2 * wid + cc, s0 = 128 * c + 2 * lane; const float* gp = GT + (size_t)(b * SEQ + s0) * 16 + 8 * dir + h;
        const float li0 = gp[0], li1 = gp[16], lf0 = logsig(gp[4]), lf1 = logsig(gp[20]);
        const float s = lf0 + lf1, incl = wscan_add(s, lane), bl1 = incl, bl0 = incl - lf1, gtot = __shfl(incl, 63);
        float a0, a1;
        if (dir == 0) { a0 = gtot - bl0 + li0; a1 = gtot - bl1 + li1; } else { a0 = bl0 - lf0 + li0; a1 = bl1 - lf1 + li1; }
        const float ma = wave_max(fmaxf(a0, a1));
        WA[s0] = expf(a0 - ma); WA[s0 + 1] = expf(a1 - ma);
        if (lane == 0) { SM[c] = gtot; SM[16 + c] = ma; }
    }
    __syncthreads();
    if (tid == 0) { float m = 0.f;
        for (int k = 0; k < 16; ++k) { const int c = dir ? 15 - k : k; const float gc = SM[c], ma = SM[16 + c], mn = fmaxf(gc + m, ma);
            SM[64 + c] = m; SM[32 + c] = expf(gc + m - mn); SM[48 + c] = expf(ma - mn); m = mn; } }
    __syncthreads();
    const int a = wid >> 1, dbase = 2 * (wid & 1);
    f32x16 acc0 = {}, acc1 = {}, nacc = {};
    const int sr = tid >> 4, sc = (tid & 15) * 8, vst0 = att::v_st(sr, sc), vst1 = att::v_st(32 + sr, sc);
    const int lbase = (int)(uintptr_t)lds;
    const int vbK = lbase + ML_KT + att::v_rd_base(lane) + a * 512, vbV = lbase + ML_VT + att::v_rd_base(lane) + dbase * 512;
    float w[3][8], bb[8]; ld_convw(cw, cb, 512 + h * 128 + sc, w, bb);
    const bf16x8 ones = {0x3F80, 0x3F80, 0x3F80, 0x3F80, 0x3F80, 0x3F80, 0x3F80, 0x3F80};
    const size_t idx0 = (size_t)((b * 4 + h) * 2 + dir) * 16;
    for (int k = 0; k < 16; ++k) {
        const int c = dir ? 15 - k : k; const size_t idx = idx0 + c;
        { bf16_t* ct = CT + idx * 16384; const int cl = lane & 31;
#pragma unroll
          for (int q = 0; q < 4; ++q) { const int dk = 32 * a + 8 * q + 4 * hi;
              v2u o0; o0.x = att::cvtpk(acc0[4 * q], acc0[4 * q + 1]); o0.y = att::cvtpk(acc0[4 * q + 2], acc0[4 * q + 3]);
              v2u o1; o1.x = att::cvtpk(acc1[4 * q], acc1[4 * q + 1]); o1.y = att::cvtpk(acc1[4 * q + 2], acc1[4 * q + 3]);
              *(GAS v2u*)(ct + (32 * dbase + cl) * 128 + dk) = o0; *(GAS v2u*)(ct + (32 * (dbase + 1) + cl) * 128 + dk) = o1; }
          if (dbase == 0 && cl == 0) {
#pragma unroll
              for (int r = 0; r < 16; ++r) NP[idx * 128 + 32 * a + att::crow(r, hi)] = nacc[r]; }
          if (tid == 0) MP[idx] = SM[64 + c]; }
        { const float sp = SM[32 + c];
#pragma unroll
          for (int r = 0; r < 16; ++r) { acc0[r] *= sp; acc1[r] *= sp; nacc[r] *= sp; } }
        { const float scs = SM[48 + c] * DKS;
#pragma unroll
          for (int tl = 0; tl < 2; ++tl)
#pragma unroll
              for (int hf = 0; hf < 2; ++hf) { const int sl = 64 * tl + 32 * hf + sr, t = 128 * c + sl; const size_t row = (size_t)b * SEQ + t;
                  float o[8]; conv_silu8(QKM + row * 1024 + 512 + h * 128 + sc, t, w, bb, o);
                  *(bf16x8*)(lds + ML_KT + tl * 16384 + (hf ? vst1 : vst0)) = pack8(o, scs * WA[t]);
                  *(bf16x8*)(lds + ML_VT + tl * 16384 + (hf ? vst1 : vst0)) = *(const GAS bf16x8*)(VM + row * 512 + h * 128 + sc); } }
        __syncthreads();
#pragma unroll
        for (int tl = 0; tl < 2; ++tl) {
#define ML_STEP(KS) { const s16x4 kl = att::tr_read<tl_off + (KS) * 4096>(vbK), kh = att::tr_read<tl_off + (KS) * 4096 + 2048>(vbK); \
            const s16x4 v0l = att::tr_read<tl_off + (KS) * 4096>(vbV), v0h = att::tr_read<tl_off + (KS) * 4096 + 2048>(vbV); \
            const s16x4 v1l = att::tr_read<tl_off + 512 + (KS) * 4096>(vbV), v1h = att::tr_read<tl_off + 512 + (KS) * 4096 + 2048>(vbV); \
            asm volatile("s_waitcnt lgkmcnt(0)" ::: "memory"); __builtin_amdgcn_sched_barrier(0); \
            const bf16x8 ka = ML_PK(kl, kh); \
            acc0 = __builtin_amdgcn_mfma_f32_32x32x16_bf16(ka, ML_PK(v0l, v0h), acc0, 0, 0, 0); \
            acc1 = __builtin_amdgcn_mfma_f32_32x32x16_bf16(ka, ML_PK(v1l, v1h), acc1, 0, 0, 0); \
            nacc = __builtin_amdgcn_mfma_f32_32x32x16_bf16(ka, ones, nacc, 0, 0, 0); }
            if (tl == 0) { constexpr int tl_off = 0; ML_STEP(0) ML_STEP(1) ML_STEP(2) ML_STEP(3) }
            else { constexpr int tl_off = 16384; ML_STEP(0) ML_STEP(1) ML_STEP(2) ML_STEP(3) }
#undef ML_STEP
        }
        __syncthreads();
    }
}

__device__ __forceinline__ void out_unit(const bf16_t* QKM, const bf16_t* VM, bf16_t* OM, const float* GT, const float* cw, const float* cb, const float* ng,
                                         const bf16_t* CT, const float* NP, const float* MP, int b, int h, int c, char* lds) {
    int tid_ = threadIdx.x; asm volatile("" : "+v"(tid_));
    const int tid = tid_, wid = tid >> 6, lane = tid & 63, r32 = lane & 31, hi = lane >> 5;
    float* XA = (float*)(lds + M3_X);
    const size_t row0 = (size_t)b * SEQ + 128 * c;
    if (wid < 2) { const int dir = wid; const size_t idx = (size_t)((b * 4 + h) * 2 + dir) * 16 + c; const float mprev = MP[idx];
        const float* gp = GT + (row0 + 2 * lane) * 16 + 8 * dir + h;
        const float li0 = gp[0], li1 = gp[16], lf0 = logsig(gp[4]), lf1 = logsig(gp[20]);
        const float incl = wscan_add(lf0 + lf1, lane), bl1 = incl, bl0 = incl - lf1, gtot = __shfl(incl, 63);
        float x0, x1, a0, a1, p0, p1;
        if (dir == 0) { x0 = bl0; x1 = bl1; a0 = li0 - x0; a1 = li1 - x1;
            const float ps = wscan_max(fmaxf(a0, a1), lane); float ex = __shfl_up(ps, 1); if (lane == 0) ex = -INFINITY; p0 = fmaxf(a0, ex); p1 = fmaxf(a1, p0); }
        else { x0 = gtot - bl0 + lf0; x1 = gtot - bl1 + lf1; a0 = li0 - x0; a1 = li1 - x1;
            const float ps = wrscan_max(fmaxf(a0, a1), lane); float ex = __shfl_down(ps, 1); if (lane == 63) ex = -INFINITY; p1 = fmaxf(a1, ex); p0 = fmaxf(a0, p1); }
        float* X = XA + dir * 128;
        X[2 * lane] = a0; X[2 * lane + 1] = a1; X[256 + 2 * lane] = fmaxf(mprev, p0); X[256 + 2 * lane + 1] = fmaxf(mprev, p1);
        X[512 + 2 * lane] = x0; X[512 + 2 * lane + 1] = x1;
        X[768 + 2 * lane] = NP[idx * 128 + 2 * lane]; X[768 + 2 * lane + 1] = NP[idx * 128 + 2 * lane + 1];
    }
    { const int sr = tid >> 4, sc = (tid & 15) * 8, kc = sc * 2;
      float w[3][8], bb[8]; ld_convw(cw, cb, 512 + h * 128 + sc, w, bb);
      const bf16_t* ctf = CT + ((size_t)((b * 4 + h) * 2 + 0) * 16 + c) * 16384; const bf16_t* ctb = CT + ((size_t)((b * 4 + h) * 2 + 1) * 16 + c) * 16384;
#pragma unroll
      for (int tl = 0; tl < 2; ++tl)
#pragma unroll
          for (int hf = 0; hf < 2; ++hf) { const int rl = 32 * hf + sr, sl = 64 * tl + rl, t = 128 * c + sl; const size_t row = (size_t)b * SEQ + t;
              float o[8]; conv_silu8(QKM + row * 1024 + 512 + h * 128 + sc, t, w, bb, o);
              *(bf16x8*)(lds + M3_K + tl * 16384 + KSWZ(rl, kc)) = pack8(o, DKS);
              *(bf16x8*)(lds + M3_V + tl * 16384 + att::v_st(rl, sc)) = *(const GAS bf16x8*)(VM + row * 512 + h * 128 + sc);
              *(bf16x8*)(lds + M3_CF + tl * 16384 + KSWZ(rl, kc)) = *(const GAS bf16x8*)(ctf + sl * 128 + sc);
              *(bf16x8*)(lds + M3_CB + tl * 16384 + KSWZ(rl, kc)) = *(const GAS bf16x8*)(ctb + sl * 128 + sc); } }
    const int dir = wid >> 2, tq = 32 * (wid & 3) + r32;
    bf16x8 qr[8];
    { const int t = 128 * c + tq; const bf16_t* qp = QKM + (row0 + tq) * 1024 + h * 128 + hi * 8;
#pragma unroll
      for (int d0 = 0; d0 < 8; ++d0) { float w[3][8], bb[8], o[8]; ld_convw(cw, cb, h * 128 + hi * 8 + 16 * d0, w, bb); conv_silu8(qp + 16 * d0, t, w, bb, o); qr[d0] = pack8(o, 1.f); } }
    __syncthreads();
    const float* X = XA + dir * 128;
    const float Mt = X[256 + tq], winter = __expf(MP[(size_t)((b * 4 + h) * 2 + dir) * 16 + c] - Mt), flo = __expf(-(X[512 + tq] + Mt));
    f32x16 o[4] = {}; float den = 0.f;
    const int vb0 = (int)(uintptr_t)lds + M3_V + att::v_rd_base(lane);
#pragma unroll
    for (int tl = 0; tl < 2; ++tl) {
        f32x16 p0, p1; att::qkt(p0, p1, (const att::bf16*)(lds + M3_K + tl * 16384), qr, r32, hi);
#pragma unroll
        for (int r = 0; r < 16; ++r) { const int s0 = 64 * tl + att::crow(r, hi), s1 = s0 + 32;
            const bool k0 = dir ? (s0 >= tq) : (s0 <= tq), k1 = dir ? (s1 >= tq) : (s1 <= tq);
            const float w0 = k0 ? __expf(fminf(X[s0] - Mt, 0.f)) : 0.f, w1 = k1 ? __expf(fminf(X[s1] - Mt, 0.f)) : 0.f;
            p0[r] *= w0; p1[r] *= w1; den += p0[r] + p1[r]; }
        bf16x8 pa0, pa1, pa2, pa3;
#define PK4(P, BASE, OUT) do { unsigned a0 = att::cvtpk(P[BASE + 0], P[BASE + 1]), a1 = att::cvtpk(P[BASE + 2], P[BASE + 3]);   \
    unsigned b0 = att::cvtpk(P[BASE + 4], P[BASE + 5]), b1 = att::cvtpk(P[BASE + 6], P[BASE + 7]);                              \
    auto r0 = __builtin_amdgcn_permlane32_swap(a0, b0, false, false); auto r1 = __builtin_amdgcn_permlane32_swap(a1, b1, false, false); \
    u32x4 w = {r0[0], r1[0], r0[1], r1[1]}; OUT = *reinterpret_cast<bf16x8*>(&w); } while (0)
        PK4(p0, 0, pa0); PK4(p0, 8, pa1); PK4(p1, 0, pa2); PK4(p1, 8, pa3);
#undef PK4
        att::pv_d0(o, vb0 + tl * 16384, pa0, pa1, pa2, pa3);
    }
    { auto rr = __builtin_amdgcn_permlane32_swap(__float_as_uint(den), __float_as_uint(den), false, false); den = __uint_as_float(rr[0]) + __uint_as_float(rr[1]); }
    { float dn = 0.f; const float* NPV = X + 768;
      const char* ctl = lds + (dir ? M3_CB : M3_CF);
#pragma unroll
      for (int kc = 0; kc < 8; ++kc) { const u32x4 qw = *reinterpret_cast<const u32x4*>(&qr[kc]); float qf[8] = {bflo(qw.x), bfhi(qw.x), bflo(qw.y), bfhi(qw.y), bflo(qw.z), bfhi(qw.z), bflo(qw.w), bfhi(qw.w)};
#pragma unroll
          for (int e = 0; e < 8; ++e) { dn += qf[e] * NPV[16 * kc + 8 * hi + e]; }
          const bf16x8 qs = pack8(qf, winter); const int cb2 = (16 * kc + 8 * hi) * 2;
#pragma unroll
          for (int d0 = 0; d0 < 4; ++d0) { const int rw = 32 * (d0 & 1) + r32;
              const bf16x8 cf = *(const bf16x8*)(ctl + (d0 >> 1) * 16384 + KSWZ(rw, cb2));
              o[d0] = __builtin_amdgcn_mfma_f32_32x32x16_bf16(qs, cf, o[d0], 0, 0, 0); } }
      { auto rr = __builtin_amdgcn_permlane32_swap(__float_as_uint(dn), __float_as_uint(dn), false, false); dn = __uint_as_float(rr[0]) + __uint_as_float(rr[1]); }
      den += winter * dn; }
    const float inv = 1.f / fmaxf(fabsf(den), flo);
    float* wsx = XA + 1024 + wid * 32;
    if (hi == 0) wsx[r32] = inv;
    asm volatile("s_waitcnt lgkmcnt(0)" ::: "memory");
    float rinv[16];
#pragma unroll
    for (int r = 0; r < 16; ++r) rinv[r] = wsx[att::crow(r, hi)];
    __syncthreads();
    float* H = (float*)lds;
    if (dir == 1) {
#pragma unroll
        for (int r = 0; r < 16; ++r) { const int t = 32 * (wid & 3) + att::crow(r, hi);
#pragma unroll
            for (int d0 = 0; d0 < 4; ++d0) H[t * 132 + 32 * d0 + r32] = o[d0][r] * rinv[r]; } }
    __syncthreads();
    if (dir == 0) {
#pragma unroll
        for (int r = 0; r < 16; ++r) { const int t = 32 * (wid & 3) + att::crow(r, hi);
#pragma unroll
            for (int d0 = 0; d0 < 4; ++d0) H[t * 132 + 32 * d0 + r32] += o[d0][r] * rinv[r]; } }
    __syncthreads();
    { const int t = tid >> 2, sg = tid & 3; const float* hp = H + t * 132 + 32 * sg; float v[32]; float s = 0.f;
#pragma unroll
      for (int e = 0; e < 32; ++e) { v[e] = hp[e]; s += v[e]; }
      s += __shfl_xor(s, 1); s += __shfl_xor(s, 2); const float mean = s * (1.f / 128.f); float q = 0.f;
#pragma unroll
      for (int e = 0; e < 32; ++e) { v[e] -= mean; q += v[e] * v[e]; }
      q += __shfl_xor(q, 1); q += __shfl_xor(q, 2); const float rstd = 1.f / sqrtf(q * (1.f / 128.f) + LN_EPS);
      bf16_t* op = OM + (row0 + t) * 512 + h * 128 + 32 * sg; const float* gp = ng + h * 128 + 32 * sg;
#pragma unroll
      for (int e8 = 0; e8 < 4; ++e8) { const v4u sw = *(const GAS v4u*)(op + 8 * e8);
          const float sg8[8] = {bflo(sw.x), bfhi(sw.x), bflo(sw.y), bfhi(sw.y), bflo(sw.z), bfhi(sw.z), bflo(sw.w), bfhi(sw.w)}; float ov[8];
#pragma unroll
          for (int e = 0; e < 8; ++e) ov[e] = v[8 * e8 + e] * rstd * gp[8 * e8 + e] * sg8[e];
          v4u r; r.x = pk2(ov[0], ov[1]); r.y = pk2(ov[2], ov[3]); r.z = pk2(ov[4], ov[5]); r.w = pk2(ov[6], ov[7]);
          *(GAS v4u*)(op + 8 * e8) = r; } }
    __syncthreads();
}
}
#ifndef MIX_MLSTM
#define MIX_MLSTM 0
#endif
#ifndef MIX_GQA
#define MIX_GQA 0
#endif
__device__ __forceinline__ void gates_unit(const bf16_t* XN, const bf16_t* WgT, const float* bias, float* GT, int t, int wave, int lane) {
    const int fr = lane & 15, fq = lane >> 4;
    const f32x4 bv = *(const GAS f32x4*)(bias + 4 * fq);
    const GAS bf16x8* bp = (const GAS bf16x8*)(WgT + fr * 1024 + 8 * fq);
#pragma unroll
    for (int blk = 0; blk < 2; ++blk) {
        const int row = 256 * t + 32 * wave + 16 * blk + fr;
        const GAS bf16x8* ap = (const GAS bf16x8*)(XN + (size_t)row * 1024 + 8 * fq);
        f32x4 acc = {0.f, 0.f, 0.f, 0.f};
#pragma unroll 8
        for (int k = 0; k < 32; ++k) acc = __builtin_amdgcn_mfma_f32_16x16x32_bf16(bp[4 * k], ap[4 * k], acc, 0, 0, 0);
        *(GAS f32x4*)(GT + (size_t)row * 16 + 4 * fq) = acc + bv;
    }
}

__device__ __forceinline__ void qk_norm_rope(bf16_t* QA, bf16_t* KA, const float* gq, const float* gk, int idx, int cnt) {
    const int j = idx & 15; constexpr int NP = MG * 8 + MG * 2;
    for (int p = idx >> 4; p < NP; p += cnt >> 4) {
        int row; bf16_t* ptr; const float* gp;
        if (p < MG * 8) { row = p >> 3; ptr = QA + (size_t)row * 1024 + (p & 7) * 128 + 8 * j; gp = gq; }
        else { const int q = p - MG * 8; row = q >> 1; ptr = KA + (size_t)row * 256 + (q & 1) * 128 + 8 * j; gp = gk; }
        const v4u w = *(const GAS v4u*)ptr;
        float x[8] = {bflo(w.x), bfhi(w.x), bflo(w.y), bfhi(w.y), bflo(w.z), bfhi(w.z), bflo(w.w), bfhi(w.w)};
        float ss = 0.f;
#pragma unroll
        for (int e = 0; e < 8; ++e) ss += x[e] * x[e];
        ss += __shfl_xor(ss, 1); ss += __shfl_xor(ss, 2); ss += __shfl_xor(ss, 4); ss += __shfl_xor(ss, 8);
        const float rs = 1.f / sqrtf(ss * (1.f / 128.f) + LN_EPS);
        const int t = row & (SEQ - 1); const float pos = (j < 8) ? (float)(t >> 6) : (float)(t & 63);
        const bool second = (j & 4) != 0;
        float o[8];
#pragma unroll
        for (int e = 0; e < 8; ++e) {
            const float xe = x[e] * rs * gp[8 * j + e];
            const float other = __shfl_xor(xe, 4);
            const int i = 8 * (j & 3) + e;
            const float ang = pos * exp2f(-(float)i * (13.287712379549449f / 32.f));
            float sn, cs; sincosf(ang, &sn, &cs);
            o[e] = second ? (xe * cs + other * sn) : (xe * cs - other * sn);
        }
        v4u r; r.x = pk2(o[0], o[1]); r.y = pk2(o[2], o[3]); r.z = pk2(o[4], o[5]); r.w = pk2(o[6], o[7]);
        *(GAS v4u*)ptr = r;
    }
}

template <class GridT>
__device__ __forceinline__ void mixer_phases(const Args& a, unsigned char* lds_raw, int g, GridT& grid, int tid, int bx, int G) {
    LAS unsigned char* lds = (LAS unsigned char*)lds_raw;
    const int lane = tid & 63, wave = __builtin_amdgcn_readfirstlane(tid >> 6);
    unsigned char* ws = a.ws;
    bf16_t* XN = (bf16_t*)(ws + WS_XN);
    {
        pg8::Gemm gm{XN, (const bf16_t*)(ws + WS_WIN), MG, NIN, DM}; pg8::StaticOrder S; S.init(MG, NIN, G, bx);
        pg8::EpiInProj E{(bf16_t*)(ws + WS_QKM), (bf16_t*)(ws + WS_VM), (bf16_t*)(ws + WS_OM), (bf16_t*)(ws + WS_QA), (bf16_t*)(ws + WS_KA), (bf16_t*)(ws + WS_VA), (bf16_t*)(ws + WS_QC), (bf16_t*)(ws + WS_GBR)};
        pg8::gemm_phase<pg8::EpiInProj, pg8::StaticOrder, true, true>(lds, gm, S, E);
        for (int t = bx; t < MG / 256; t += G) gates_unit(XN, (const bf16_t*)(ws + WS_WG), a.in[7], (float*)(ws + WS_GT), t, wave, lane);
    }
    __syncthreads();
    grid.sync();
    {
        const int c = bx >= 192 ? bx - 192 : 1 << 20;
        pg8::Gemm gm{(const bf16_t*)(ws + WS_MEMB) + (size_t)g * MEMR * DM, (const bf16_t*)(ws + WS_WMEM), MEMR, 1024, DM}; pg8::StaticOrder S; S.init(MEMR, 1024, 64, c);
        pg8::EpiSplit E{(bf16_t*)(ws + WS_KC), 512, 512, (WS_VC - WS_KC) / 2};
        pg8::gemm_phase<pg8::EpiSplit, pg8::StaticOrder, true, true>(lds, gm, S, E);
#if MIX_MLSTM
        if (bx < 64) ml::scan_item((const bf16_t*)(ws + WS_QKM), (const bf16_t*)(ws + WS_VM), (const float*)(ws + WS_GT), a.in[8], a.in[9],
                                    (bf16_t*)(ws + WS_CT), (float*)(ws + WS_NP), (float*)(ws + WS_NP) + 1024 * 128, bx >> 3, (bx >> 1) & 3, bx & 1, (char*)lds_raw);
#endif
#if MIX_GQA
        qk_norm_rope((bf16_t*)(ws + WS_QA), (bf16_t*)(ws + WS_KA), a.in[11], a.in[12], bx * NTHR + tid, G * NTHR);
#endif
    }
    __syncthreads();
    grid.sync();
    {
#if MIX_GQA
        { const int vcu = (G % 8 == 0) ? (bx % 8) * (G / 8) + bx / 8 : bx;
          for (int u = vcu; u < BG * 8 * 8; u += G) {
            const int b = u >> 6, h = (u >> 3) & 7, qb = u & 7;
            att::bf16* Q = (att::bf16*)(ws + WS_QA) + (size_t)(b * SEQ + qb * 256) * 1024 + h * 128;
            const att::bf16* K = (const att::bf16*)(ws + WS_KA) + (size_t)(b * SEQ) * 256 + (h >> 2) * 128;
            const att::bf16* V = (const att::bf16*)(ws + WS_VA) + (size_t)(b * SEQ) * 256 + (h >> 2) * 128;
            att::attn_dense_body<1024, 256>(Q, K, V, Q, SEQ, (char*)lds_raw);
          } }
#endif
#if MIX_MLSTM
        for (int u = bx; u < BG * 4 * 16; u += G)
            ml::out_unit((const bf16_t*)(ws + WS_QKM), (const bf16_t*)(ws + WS_VM), (bf16_t*)(ws + WS_OM), (const float*)(ws + WS_GT), a.in[8], a.in[9], a.in[10],
                         (const bf16_t*)(ws + WS_CT), (const float*)(ws + WS_NP), (const float*)(ws + WS_NP) + 1024 * 128, u >> 6, (u >> 4) & 3, u & 15, (char*)lds_raw);
#endif
        for (int u = bx; u < BG * 4 * 8; u += G) {
            const int b = u >> 5, h = (u >> 3) & 3, qb = u & 7;
            att::bf16* Q = (att::bf16*)(ws + WS_QC) + (size_t)(b * SEQ + qb * 256) * 512 + h * 128;
            const att::bf16* K = (const att::bf16*)(ws + WS_KC) + (size_t)(b * NMEM) * 512 + h * 128;
            const att::bf16* V = (const att::bf16*)(ws + WS_VC) + (size_t)(b * NMEM) * 512 + h * 128;
            att::attn_dense_body<512, 512>(Q, K, V, Q, NMEM, (char*)lds_raw);
        }
    }
    __syncthreads();
    grid.sync();
    {
        pg8::StaticOrder S; S.init(MG, DM, G, bx);
        float* SCR = (float*)(ws + WS_SCR); bf16_t* MERGED = (bf16_t*)(ws + WS_MERGED); const bf16_t* GBR = (const bf16_t*)(ws + WS_GBR);
#if MIX_MLSTM
        { pg8::Gemm gm{(const bf16_t*)(ws + WS_OM), (const bf16_t*)(ws + WS_WBM), MG, DM, 512}; pg8::EpiMerge<0> E{GBR, 0, SCR, MERGED};
          pg8::gemm_phase<pg8::EpiMerge<0>, pg8::StaticOrder, true, true>(lds, gm, S, E); }
#endif
#if MIX_GQA
        { pg8::Gemm gm{(const bf16_t*)(ws + WS_QA), (const bf16_t*)(ws + WS_WBA), MG, DM, 1024}; pg8::EpiMerge<MIX_MLSTM ? 1 : 0> E{GBR, 1024, SCR, MERGED};
          pg8::gemm_phase<pg8::EpiMerge<MIX_MLSTM ? 1 : 0>, pg8::StaticOrder, true, true>(lds, gm, S, E); }
#endif
        { constexpr int MODE = (MIX_MLSTM || MIX_GQA) ? 2 : 3;
          pg8::Gemm gm{(const bf16_t*)(ws + WS_QC), (const bf16_t*)(ws + WS_WBC), MG, DM, 512}; pg8::EpiMerge<MODE> E{GBR, 2048, SCR, MERGED};
          pg8::gemm_phase<pg8::EpiMerge<MODE>, pg8::StaticOrder, true, true>(lds, gm, S, E); }
    }
    __syncthreads();
    grid.sync();
}

__device__ __forceinline__ int map_win(int n) { return n < 2048 ? n : n + 16; }
__device__ __forceinline__ int map_id(int n) { return n; }
__device__ __forceinline__ int map_up(int n) { return ((n >> 7) & 1) * DFF + (n >> 8) * 128 + (n & 127); }

__device__ __forceinline__ void p0_weights(const Args& a, LAS unsigned char* lds, int gw, int NGW, int wave, int lane, int gtid, int ngt) {
    LAS float* scr = (LAS float*)(lds + wave * 16384);
    unsigned char* ws = a.ws;
#define TRI(W, NSRC, K, NDST, WT, MAP) { constexpr int NI = ((K) / 64) * ((NDST) / 32); if (r < NI) { const int kb = r / ((NDST) / 32), nb = r % ((NDST) / 32); \
        transpose_item(W, NSRC, K, (bf16_t*)(ws + (WT)), 64 * kb, 32 * nb, MAP(32 * nb), scr, lane); continue; } r -= NI; }
    constexpr int NITEMS = 16 * 224 + 16 * 32 + 8 * 32 + 16 * 32 + 8 * 32 + 16 * 32 + 16 * 176 + 44 * 32;
    for (int it = gw; it < NITEMS; it += NGW) {
        int r = it;
        TRI(a.in[6], INW, 1024, NIN, WS_WIN, map_win)
        TRI(a.in[13], 1024, 1024, 1024, WS_WMEM, map_id)
        TRI(a.in[14], 1024, 512, 1024, WS_WBM, map_id)
        TRI(a.in[15], 1024, 1024, 1024, WS_WBA, map_id)
        TRI(a.in[16], 1024, 512, 1024, WS_WBC, map_id)
        TRI(a.in[17], 1024, 1024, 1024, WS_WOUT, map_id)
        TRI(a.in[20], NUP, 1024, NUP, WS_WUP, map_up)
        TRI(a.in[23], 1024, DFF, 1024, WS_WDN, map_id)
    }
#undef TRI
    { bf16_t* wg = (bf16_t*)(ws + WS_WG); const GAS float* win = (const GAS float*)a.in[6];
      for (int i = gtid; i < 16 * 1024; i += ngt) { const int c = i >> 10, k = i & 1023; wg[i] = (bf16_t)(pk2(win[(size_t)k * INW + 2048 + c], 0.f) & 0xffffu); } }
    { bf16_t* mb = (bf16_t*)(ws + WS_MEMB); const int n8p = 8 * NMEM * DM / 8, n8 = 24 * NMEM * DM / 8;
      for (int i = gtid; i < n8; i += ngt) { const GAS f32x4* s = (i < n8p) ? (const GAS f32x4*)a.in[2] + 2 * (size_t)i : (const GAS f32x4*)a.in[3] + 2 * (size_t)(i - n8p);
          const f32x4 x0 = s[0], x1 = s[1]; v4u o; o.x = pk2(x0.x, x0.y); o.y = pk2(x0.z, x0.w); o.z = pk2(x1.x, x1.y); o.w = pk2(x1.z, x1.w); ((GAS v4u*)mb)[i] = o; } }
}

__device__ __forceinline__ void conv_pass(const bf16_t* U1, const bf16_t* U2, bf16_t* HID, const float* cw, const float* cb, int gtid, int ngt) {
    constexpr int CC = DFF / 8, RB = 16, TOTAL = (MG / RB) * CC;
    for (int it = gtid; it < TOTAL; it += ngt) {
        const int cc = it % CC, rb = it / CC, c = 8 * cc, r0 = rb * RB;
        float w1[3][8], w2[3][8], b1[8], b2[8];
#pragma unroll
        for (int j = 0; j < 3; ++j)
#pragma unroll
            for (int e = 0; e < 8; ++e) { w1[j][e] = cw[j * NUP + c + e]; w2[j][e] = cw[j * NUP + DFF + c + e]; }
#pragma unroll
        for (int e = 0; e < 8; ++e) { b1[e] = cb[c + e]; b2[e] = cb[DFF + c + e]; }
        const GAS v4u* p1 = (const GAS v4u*)(U1 + (size_t)r0 * DFF + c); const GAS v4u* p2 = (const GAS v4u*)(U2 + (size_t)r0 * DFF + c);
        constexpr int RS = DFF / 8;
        v4u a1, a2, c1, c2, n1, n2; const v4u z = {0u, 0u, 0u, 0u};
        if ((r0 % SEQ) == 0) { a1 = z; a2 = z; } else { a1 = p1[-RS]; a2 = p2[-RS]; }
        c1 = p1[0]; c2 = p2[0];
#pragma unroll 4
        for (int i = 0; i < RB; ++i) {
            const bool last = (i == RB - 1) && (((r0 + RB) % SEQ) == 0);
            if (last) { n1 = z; n2 = z; } else { n1 = p1[(size_t)(i + 1) * RS]; n2 = p2[(size_t)(i + 1) * RS]; }
            float o[8];
#pragma unroll
            for (int q = 0; q < 4; ++q) {
                const float y1l = w1[0][2 * q] * bflo(a1[q]) + w1[1][2 * q] * bflo(c1[q]) + w1[2][2 * q] * bflo(n1[q]) + b1[2 * q];
                const float y1h = w1[0][2 * q + 1] * bfhi(a1[q]) + w1[1][2 * q + 1] * bfhi(c1[q]) + w1[2][2 * q + 1] * bfhi(n1[q]) + b1[2 * q + 1];
                const float y2l = w2[0][2 * q] * bflo(a2[q]) + w2[1][2 * q] * bflo(c2[q]) + w2[2][2 * q] * bflo(n2[q]) + b2[2 * q];
                const float y2h = w2[0][2 * q + 1] * bfhi(a2[q]) + w2[1][2 * q + 1] * bfhi(c2[q]) + w2[2][2 * q + 1] * bfhi(n2[q]) + b2[2 * q + 1];
                o[2 * q] = gelu_tanh(y1l) * y2l; o[2 * q + 1] = gelu_tanh(y1h) * y2h; }
            v4u w; w.x = pk2(o[0], o[1]); w.y = pk2(o[2], o[3]); w.z = pk2(o[4], o[5]); w.w = pk2(o[6], o[7]);
            *(GAS v4u*)(HID + (size_t)(r0 + i) * DFF + c) = w;
            a1 = c1; a2 = c2; c1 = n1; c2 = n2;
        }
    }
}
#ifndef ENABLE_MIX
#define ENABLE_MIX 0
#endif
__global__ void __launch_bounds__(NTHR, 2) mega_fwd(Args a) {
    extern __shared__ __attribute__((aligned(16))) unsigned char lds_raw[];
    LAS unsigned char* lds = (LAS unsigned char*)lds_raw;
    cg::grid_group grid = cg::this_grid();
    const int G = gridDim.x, NGW = G * NWAVES, ngt = G * NTHR;
    {
        const int tid = threadIdx.x, lane = tid & 63, wave = __builtin_amdgcn_readfirstlane(tid >> 6), bx = blockIdx.x;
        p0_weights(a, lds, bx * NWAVES + wave, NGW, wave, lane, bx * NTHR + tid, ngt);
    }
    for (int g = 0; g < NGRP; ++g) {
        int tid_ = threadIdx.x, bx_ = blockIdx.x; asm volatile("" : "+v"(tid_), "+s"(bx_));
        const int tid = tid_, bx = bx_, lane = tid & 63, wave = __builtin_amdgcn_readfirstlane(tid >> 6);
        const int gw = bx * NWAVES + wave, gtid = bx * NTHR + tid;
        unsigned char* ws = a.ws;
        bf16_t* XN = (bf16_t*)(ws + WS_XN); float* STATS = (float*)(ws + WS_STATS);
        const float* xg = (g == 0) ? a.in[0] : a.in[1] + (size_t)(g - 1) * MG * DM;
        float* outg = a.out + (size_t)g * MG * DM;
        for (int m = gw; m < MG; m += NGW) ln_row(xg + (size_t)m * DM, a.in[4], a.in[5], nullptr, XN + (size_t)m * DM, STATS + 2 * m, lane);
        __syncthreads();
        grid.sync();
#if ENABLE_MIX
        mixer_phases(a, lds_raw, g, grid, tid, bx, G);
#endif
        {
#if ENABLE_MIX
            pg8::Gemm gm{(const bf16_t*)(ws + WS_MERGED), (const bf16_t*)(ws + WS_WOUT), MG, DM, DM}; pg8::StaticOrder S; S.init(MG, DM, G, bx);
            pg8::EpiWout E{xg, STATS, a.in[4], a.in[5], outg, ALPHA};
            pg8::gemm_phase<pg8::EpiWout, pg8::StaticOrder, true, true>(lds, gm, S, E);
#else
            for (int i = gtid; i < MG * DM / 4; i += ngt) { const int row = i >> 8, c4 = i & 255; const f32x4 xv = ((const GAS f32x4*)xg)[i];
                const f32x4 gv = ((const GAS f32x4*)a.in[4])[c4], bv = ((const GAS f32x4*)a.in[5])[c4];
                ((GAS f32x4*)outg)[i] = ((xv - STATS[2 * row]) * STATS[2 * row + 1] * gv + bv) * ALPHA; }
#endif
        }
        __syncthreads();
        grid.sync();
        for (int m = gw; m < MG; m += NGW) ln_row(outg + (size_t)m * DM, a.in[18], a.in[19], outg + (size_t)m * DM, XN + (size_t)m * DM, nullptr, lane);
        __syncthreads();
        grid.sync();
        {
            pg8::Gemm gm{XN, (const bf16_t*)(ws + WS_WUP), MG, NUP, DM}; pg8::StaticOrder S; S.init(MG, NUP, G, bx);
            pg8::EpiUp E{(bf16_t*)(ws + WS_U1), (bf16_t*)(ws + WS_U2), DFF};
            pg8::gemm_phase<pg8::EpiUp, pg8::StaticOrder, true, true>(lds, gm, S, E);
        }
        __syncthreads();
        grid.sync();
        conv_pass((const bf16_t*)(ws + WS_U1), (const bf16_t*)(ws + WS_U2), (bf16_t*)(ws + WS_HID), a.in[21], a.in[22], gtid, ngt);
        __syncthreads();
        grid.sync();
        {
            pg8::Gemm gm{(const bf16_t*)(ws + WS_HID), (const bf16_t*)(ws + WS_WDN), MG, DM, DFF}; pg8::StaticOrder S; S.init(MG, DM, G, bx);
            pg8::EpiResF32 E{outg, DM, ALPHA};
            pg8::gemm_phase<pg8::EpiResF32, pg8::StaticOrder, true, true>(lds, gm, S, E);
        }
        __syncthreads();
        grid.sync();
        for (int m = gw; m < MG; m += NGW) ln_row(outg + (size_t)m * DM, a.in[24], a.in[25], outg + (size_t)m * DM, nullptr, nullptr, lane);
    }
}

extern "C" void kernel_launch(void* const* d_in, const int* in_sizes, int n_in, void* d_out, int out_size, void* d_ws, size_t ws_size, hipStream_t stream) {
    static int grid = 0;
    if (grid == 0) {
        if (n_in != 26 || ws_size < WS_END || out_size != 3 * MG * DM) { fprintf(stderr, "kernel_launch: unexpected shapes: n_in %d out %d ws %zu (need %zu)\n", n_in, out_size, ws_size, (size_t)WS_END); grid = -1; return; }
        int dev = 0, cus = 0, per_cu = 0;
        if (hipGetDevice(&dev) != hipSuccess || hipDeviceGetAttribute(&cus, hipDeviceAttributeMultiprocessorCount, dev) != hipSuccess) { grid = -1; return; }
        if (hipFuncSetAttribute((const void*)mega_fwd, hipFuncAttributeMaxDynamicSharedMemorySize, LDS_BYTES) != hipSuccess) { fprintf(stderr, "kernel_launch: hipFuncSetAttribute failed\n"); grid = -1; return; }
        if (hipOccupancyMaxActiveBlocksPerMultiprocessor(&per_cu, (const void*)mega_fwd, NTHR, LDS_BYTES) != hipSuccess || per_cu < 1) { fprintf(stderr, "kernel_launch: occupancy query failed (%d)\n", per_cu); per_cu = 1; }
        (void)hipGetLastError();
        grid = cus;
    }
    if (grid < 0) return;
    Args a{};
    for (int i = 0; i < 26; ++i) a.in[i] = (const float*)d_in[i];
    a.out = (float*)d_out; a.ws = (unsigned char*)d_ws;
    void* args[] = {&a};
    hipError_t e = hipLaunchCooperativeKernel((const void*)mega_fwd, dim3(grid), dim3(NTHR), args, LDS_BYTES, stream);
    if (e != hipSuccess) fprintf(stderr, "kernel_launch: cooperative launch failed: %s (grid %d)\n", hipGetErrorString(e), grid);
}
```

```cpp
#include <hip/hip_runtime.h>
#include <hip/hip_cooperative_groups.h>
#include <cstdio>
#include <cstdint>
namespace cg = cooperative_groups;
#define ENABLE_MIX 1
#define MIX_MLSTM 1
#define MIX_GQA 1
namespace pg8 {
#define PG8_LAS __attribute__((address_space(3)))
typedef unsigned short bf16_t;
typedef short bf16x8 __attribute__((ext_vector_type(8)));
typedef float f32x4 __attribute__((ext_vector_type(4)));
typedef unsigned u32x4 __attribute__((ext_vector_type(4)));
constexpr int BM = 256, BK = 64, HALF = 128, HTB = HALF * BK * 2  , STAGE_BYTES = 8 * HTB, NXCD = 8, WGM = 8;

__host__ __device__ __forceinline__ int lds_byte(int r, int c) { const int st = (r >> 4) * 2 + (c >> 5), rr = r & 15, cc = c & 31, ob = rr * 64 + cc * 2; return st * 1024 + (ob ^ (((ob >> 9) & 1) << 5)); }
__host__ __device__ __forceinline__ void stage_rc(int b, int& R, int& C) { const int st = b / 1024, sb = b % 1024, swz = sb ^ (((sb >> 9) & 1) << 5); R = (st >> 1) * 16 + swz / 64; C = (st & 1) * 32 + (swz % 64) / 2; }
__host__ __device__ __forceinline__ int perm32(int rho) { const int n = rho >> 4, i = rho & 15; return 8 * (i >> 2) + 4 * n + (i & 3); }

struct Unit { int pm, pn; };
struct Gemm { const bf16_t* A; const bf16_t* Bt; int M, N, K; };

struct StaticOrder {
    int nM, nN, nwg, G, c;
    __host__ __device__ void init(int M, int N, int G_, int c_) { nM = M / BM; nN = N / BM; nwg = nM * nN; G = G_; c = c_; }
    __host__ __device__ bool next(int i, Unit& u) const {
        const long L = (long)i * G + c; if (L >= nwg) return false;
        int wgid = (int)L; { const int q = nwg / NXCD, r = nwg % NXCD, xcd = wgid % NXCD, off = wgid / NXCD; wgid = (xcd < r ? xcd * (q + 1) : r * (q + 1) + (xcd - r) * q) + off; }
        const int nig = WGM * nN, gid = wgid / nig, fm = gid * WGM, gsz = (nM - fm) < WGM ? (nM - fm) : WGM;
        u.pm = fm + ((wgid % nig) % gsz); u.pn = (wgid % nig) / gsz; return true;
    }
    __device__ __forceinline__ void a_ready(const Unit&) const {}
    __device__ __forceinline__ void done(const Unit&) const {}
};

__device__ __forceinline__ unsigned cvt_pk_bf16(float lo, float hi) { unsigned r; asm volatile("v_cvt_pk_bf16_f32 %0, %1, %2" : "=v"(r) : "v"(lo), "v"(hi)); return r; }
typedef float f32x2 __attribute__((ext_vector_type(2)));
__device__ __forceinline__ f32x2 gelu_pk(f32x2 v) {
    const f32x2 av = __builtin_elementwise_abs(v), d = av * 0.2316418882f + 1.0f;
    f32x2 t; t.x = __builtin_amdgcn_rcpf(d.x); t.y = __builtin_amdgcn_rcpf(d.y);
    f32x2 q = t * 0.5307027145f + (-0.7265760135f); q = q * t + 0.7107068705f; q = q * t + (-0.142248368f); q = q * t + 0.127414796f; q = q * t;
    const f32x2 s = (v * v) * (-0.72134752044f);
    f32x2 e; e.x = __builtin_amdgcn_exp2f(s.x); e.y = __builtin_amdgcn_exp2f(s.y);
    const f32x2 m = v * (q * e), r = v - m;
    f32x2 o; o.x = v.x < 0.f ? m.x : r.x; o.y = v.y < 0.f ? m.y : r.y; return o;
}

#define PG8_GAS __attribute__((address_space(1)))
__device__ __forceinline__ float sigm(float x) { return __builtin_amdgcn_rcpf(1.0f + __expf(-x)); }
__device__ __forceinline__ void st8_bf16(bf16_t* p, const f32x4 v0, const f32x4 v1) {
    u32x4 w; w.x = cvt_pk_bf16(v0[0], v0[1]); w.y = cvt_pk_bf16(v0[2], v0[3]); w.z = cvt_pk_bf16(v1[0], v1[1]); w.w = cvt_pk_bf16(v1[2], v1[3]);
    *(PG8_GAS u32x4*)p = w;
}
__device__ __forceinline__ void ld8_bf16(const bf16_t* p, f32x4& v0, f32x4& v1) {
    const u32x4 w = *(const PG8_GAS u32x4*)p;
    v0[0] = __uint_as_float(w.x << 16); v0[1] = __uint_as_float(w.x & 0xffff0000u); v0[2] = __uint_as_float(w.y << 16); v0[3] = __uint_as_float(w.y & 0xffff0000u);
    v1[0] = __uint_as_float(w.z << 16); v1[1] = __uint_as_float(w.z & 0xffff0000u); v1[2] = __uint_as_float(w.w << 16); v1[3] = __uint_as_float(w.w & 0xffff0000u);
}
struct EpiInProj {
    static constexpr bool PERM = true, AFTER_DRAIN = false;
    bf16_t *QKM, *VM, *OM, *QA, *KA, *VA, *QC, *GBR;
    __device__ __forceinline__ void operator()(const f32x4 (&acc)[2][2][4][2], const Unit& u, int wr, int wc, int fr, int fq) const {
        const int pn = u.pn; bf16_t* base; int ld, cb; bool act = false;
        if (pn < 4) { base = QKM; ld = 1024; cb = 256 * pn; }
        else if (pn < 6) { base = VM; ld = 512; cb = 256 * (pn - 4); }
        else if (pn < 8) { base = OM; ld = 512; cb = 256 * (pn - 6); act = true; }
        else if (pn < 12) { base = QA; ld = 1024; cb = 256 * (pn - 8); }
        else if (pn == 12) { base = KA; ld = 256; cb = 0; }
        else if (pn == 13) { base = VA; ld = 256; cb = 0; }
        else if (pn < 16) { base = QC; ld = 512; cb = 256 * (pn - 14); }
        else { base = GBR; ld = 3072; cb = 256 * (pn - 16); act = true; }
        const int row0 = u.pm * BM + wr * 64 + fr, col0 = cb + wc * 32 + 8 * fq;
#pragma unroll
        for (int ai = 0; ai < 2; ++ai)
#pragma unroll
            for (int m = 0; m < 4; ++m) { bf16_t* rowp = base + (size_t)(row0 + ai * HALF + m * 16) * ld + col0;
#pragma unroll
                for (int bj = 0; bj < 2; ++bj) { f32x4 v0 = acc[ai][bj][m][0], v1 = acc[ai][bj][m][1];
                    if (act) {
#pragma unroll
                        for (int e = 0; e < 4; ++e) { v0[e] = sigm(v0[e]); v1[e] = sigm(v1[e]); } }
                    st8_bf16(rowp + bj * HALF, v0, v1); } }
    }
};
struct EpiSplit {
    static constexpr bool PERM = true, AFTER_DRAIN = false;
    bf16_t* O; int ld, split; size_t stride;
    __device__ __forceinline__ void operator()(const f32x4 (&acc)[2][2][4][2], const Unit& u, int wr, int wc, int fr, int fq) const {
        int colt = u.pn * BM; const int t = colt / split; colt -= t * split; bf16_t* base = O + (size_t)t * stride;
        const int row0 = u.pm * BM + wr * 64 + fr, col0 = colt + wc * 32 + 8 * fq;
#pragma unroll
        for (int ai = 0; ai < 2; ++ai)
#pragma unroll
            for (int m = 0; m < 4; ++m) { bf16_t* rowp = base + (size_t)(row0 + ai * HALF + m * 16) * ld + col0;
#pragma unroll
                for (int bj = 0; bj < 2; ++bj) st8_bf16(rowp + bj * HALF, acc[ai][bj][m][0], acc[ai][bj][m][1]); }
    }
};
struct EpiUp {
    static constexpr bool PERM = true, AFTER_DRAIN = false;
    bf16_t *U1, *U2; int ld;
    __device__ __forceinline__ void operator()(const f32x4 (&acc)[2][2][4][2], const Unit& u, int wr, int wc, int fr, int fq) const {
        const int row0 = u.pm * BM + wr * 64 + fr, col0 = u.pn * HALF + wc * 32 + 8 * fq;
#pragma unroll
        for (int ai = 0; ai < 2; ++ai)
#pragma unroll
            for (int m = 0; m < 4; ++m) { const size_t off = (size_t)(row0 + ai * HALF + m * 16) * ld + col0;
                st8_bf16(U1 + off, acc[ai][0][m][0], acc[ai][0][m][1]); st8_bf16(U2 + off, acc[ai][1][m][0], acc[ai][1][m][1]); }
    }
};
struct EpiResF32 {
    static constexpr bool PERM = true, AFTER_DRAIN = false;
    float* out; int ld; float alpha;
    __device__ __forceinline__ void operator()(const f32x4 (&acc)[2][2][4][2], const Unit& u, int wr, int wc, int fr, int fq) const {
        const int row0 = u.pm * BM + wr * 64 + fr, col0 = u.pn * BM + wc * 32 + 8 * fq;
#pragma unroll
        for (int ai = 0; ai < 2; ++ai)
#pragma unroll
            for (int m = 0; m < 4; ++m) { float* rowp = out + (size_t)(row0 + ai * HALF + m * 16) * ld + col0;
#pragma unroll
                for (int bj = 0; bj < 2; ++bj) { PG8_GAS f32x4* p = (PG8_GAS f32x4*)(rowp + bj * HALF);
                    const f32x4 a0 = p[0], a1 = p[1]; p[0] = a0 * alpha + acc[ai][bj][m][0]; p[1] = a1 * alpha + acc[ai][bj][m][1]; } }
    }
};
struct EpiWout {
    static constexpr bool PERM = true, AFTER_DRAIN = false;
    const float* x; const float* stats; const float* g; const float* b; float* out; float alpha;
    __device__ __forceinline__ void operator()(const f32x4 (&acc)[2][2][4][2], const Unit& u, int wr, int wc, int fr, int fq) const {
        const int row0 = u.pm * BM + wr * 64 + fr, col0 = u.pn * BM + wc * 32 + 8 * fq;
        f32x4 gv[2][2], bv[2][2];
#pragma unroll
        for (int bj = 0; bj < 2; ++bj)
#pragma unroll
            for (int n = 0; n < 2; ++n) { gv[bj][n] = *(const PG8_GAS f32x4*)(g + col0 + bj * HALF + 4 * n); bv[bj][n] = *(const PG8_GAS f32x4*)(b + col0 + bj * HALF + 4 * n); }
#pragma unroll
        for (int ai = 0; ai < 2; ++ai)
#pragma unroll
            for (int m = 0; m < 4; ++m) { const int row = row0 + ai * HALF + m * 16; const size_t off = (size_t)row * 1024 + col0;
                const float mu = stats[2 * row], rs = stats[2 * row + 1];
#pragma unroll
                for (int bj = 0; bj < 2; ++bj)
#pragma unroll
                    for (int n = 0; n < 2; ++n) { const f32x4 xv = *(const PG8_GAS f32x4*)(x + off + bj * HALF + 4 * n);
                        const f32x4 xn = (xv - mu) * rs * gv[bj][n] + bv[bj][n];
                        *(PG8_GAS f32x4*)(out + off + bj * HALF + 4 * n) = xn * alpha + acc[ai][bj][m][n]; } }
    }
};
template <int MODE> struct EpiMerge {
    static constexpr bool PERM = true, AFTER_DRAIN = false;
    const bf16_t* GBR; int goff; float* S; bf16_t* MERGED;
    __device__ __forceinline__ void operator()(const f32x4 (&acc)[2][2][4][2], const Unit& u, int wr, int wc, int fr, int fq) const {
        const int row0 = u.pm * BM + wr * 64 + fr, col0 = u.pn * BM + wc * 32 + 8 * fq;
#pragma unroll
        for (int ai = 0; ai < 2; ++ai)
#pragma unroll
            for (int m = 0; m < 4; ++m) { const int row = row0 + ai * HALF + m * 16;
#pragma unroll
                for (int bj = 0; bj < 2; ++bj) { const int c = col0 + bj * HALF; f32x4 g0, g1; ld8_bf16(GBR + (size_t)row * 3072 + goff + c, g0, g1);
                    f32x4 v0 = g0 * acc[ai][bj][m][0], v1 = g1 * acc[ai][bj][m][1];
                    PG8_GAS f32x4* sp = (PG8_GAS f32x4*)(S + (size_t)row * 1024 + c);
                    if (MODE == 1 || MODE == 2) { v0 += sp[0]; v1 += sp[1]; }
                    if (MODE <= 1) { sp[0] = v0; sp[1] = v1; } else st8_bf16(MERGED + (size_t)row * 1024 + c, v0, v1); } }
    }
};
template <class Epi, class Sched, bool ALIGN_EPI = false, bool SP2 = false>
__device__ __forceinline__ void gemm_phase(PG8_LAS unsigned char* lds, const Gemm g, const Sched& S, const Epi& E) {
    int tid_ = threadIdx.x; asm volatile("" : "+v"(tid_));
    const int tid = tid_, wid = __builtin_amdgcn_readfirstlane(tid >> 6), lane = tid & 63, wr = wid >> 2, wc = wid & 3, fr = lane & 15, fq = lane >> 4;
    const int K = g.K, nt = K / BK;
    unsigned voffA[2], voffB[2];
#pragma unroll
    for (int i = 0; i < 2; ++i) { int R, C; stage_rc(tid * 16 + i * 8192, R, C); const int Rb = Epi::PERM ? ((R & ~31) + perm32(R & 31)) : R;
        voffA[i] = (unsigned)(R * K + C) * 2u; voffB[i] = (unsigned)(Rb * K + C) * 2u; }
    const size_t kstep = (size_t)(BK * 2);
    const size_t hstep = (size_t)HALF * K * 2;
    const size_t tstep = 2 * hstep;
    const unsigned ldsw = (unsigned)wid * 1024u;
    const int aoff = lds_byte(wr * 64 + fr, fq * 8), boff = lds_byte(wc * 32 + fr, fq * 8);
#define PG8_SA(b, h) (((b) * 2 + (h)) * HTB)
#define PG8_SB(b, h) ((4 + (b) * 2 + (h)) * HTB)
#define PG8_STAGE(bufoff, gbase, voff) do { _Pragma("unroll") for (int _i = 0; _i < 2; ++_i) \
        __builtin_amdgcn_global_load_lds((const unsigned*)((const char*)(gbase) + (voff)[_i]), (PG8_LAS unsigned*)(lds + (bufoff) + ldsw + _i * 8192), 16, 0, 0); } while (0)
#define PG8_LDA(dst, b, h) do { _Pragma("unroll") for (int m = 0; m < 4; ++m) _Pragma("unroll") for (int k = 0; k < 2; ++k) dst[m][k] = *(const PG8_LAS bf16x8*)(lds + PG8_SA(b, h) + aoff + m * 2048 + k * 1024); } while (0)
#define PG8_LDB(dst, b, h) do { _Pragma("unroll") for (int n = 0; n < 2; ++n) _Pragma("unroll") for (int k = 0; k < 2; ++k) dst[n][k] = *(const PG8_LAS bf16x8*)(lds + PG8_SB(b, h) + boff + n * 2048 + k * 1024); } while (0)
#define PG8_MMA(ai, bj, At, Bt) do { __builtin_amdgcn_s_setprio(1); _Pragma("unroll") for (int m = 0; m < 4; ++m) _Pragma("unroll") for (int n = 0; n < 2; ++n) _Pragma("unroll") for (int k = 0; k < 2; ++k) \
        acc[ai][bj][m][n] = __builtin_amdgcn_mfma_f32_16x16x32_bf16(Bt[n][k], At[m][k], acc[ai][bj][m][n], 0, 0, 0); __builtin_amdgcn_s_setprio(0); } while (0)
#define PG8_WAIT_V(n) asm volatile("s_waitcnt vmcnt(" #n ")" ::: "memory")
#define PG8_WAIT_L(n) asm volatile("s_waitcnt lgkmcnt(" #n ")" ::: "memory")
#define PG8_BAR __builtin_amdgcn_s_barrier()
#define PG8_SCHED __builtin_amdgcn_sched_barrier(0)
    Unit cur, nxt; int ui = 0;
    if (!S.next(0, cur)) return;
    f32x4 acc[2][2][4][2];
#pragma unroll
    for (int a = 0; a < 2; ++a)
#pragma unroll
        for (int b = 0; b < 2; ++b)
#pragma unroll
            for (int m = 0; m < 4; ++m)
#pragma unroll
                for (int n = 0; n < 2; ++n) acc[a][b][m][n] = (f32x4){0.f, 0.f, 0.f, 0.f};
    bf16x8 At[4][2], B0[2][2], B1[2][2];
    const char* cA = (const char*)g.A + (size_t)cur.pm * tstep; const char* cB = (const char*)g.Bt + (size_t)cur.pn * tstep;
    S.a_ready(cur);
    if constexpr (SP2) {
        PG8_STAGE(PG8_SB(0, 0), cB, voffB); PG8_STAGE(PG8_SB(0, 1), cB + hstep, voffB); PG8_STAGE(PG8_SA(0, 0), cA, voffA); PG8_STAGE(PG8_SA(0, 1), cA + hstep, voffA);
        if (wr == 1) PG8_BAR;
        PG8_WAIT_V(2); PG8_BAR;
        PG8_STAGE(PG8_SB(1, 0), cB + kstep, voffB); PG8_STAGE(PG8_SA(1, 0), cA + kstep, voffA); PG8_STAGE(PG8_SB(1, 1), cB + hstep + kstep, voffB);
        PG8_WAIT_V(6); PG8_BAR;
    } else {
        PG8_STAGE(PG8_SB(0, 0), cB, voffB); PG8_STAGE(PG8_SA(0, 0), cA, voffA); PG8_STAGE(PG8_SB(0, 1), cB + hstep, voffB); PG8_STAGE(PG8_SA(0, 1), cA + hstep, voffA);
        if (wr == 1) PG8_BAR;
        PG8_WAIT_V(4); PG8_BAR;
        PG8_STAGE(PG8_SB(1, 0), cB + kstep, voffB); PG8_STAGE(PG8_SA(1, 0), cA + kstep, voffA); PG8_STAGE(PG8_SB(1, 1), cB + hstep + kstep, voffB);
        PG8_WAIT_V(6); PG8_BAR;
    }
    for (;;) {
        const bool has_next = S.next(ui + 1, nxt);
        const char* nA = has_next ? (const char*)g.A + (size_t)nxt.pm * tstep : cA; const char* nB = has_next ? (const char*)g.Bt + (size_t)nxt.pn * tstep : cB;
        for (int t = 0; t < nt; t += 2) {
            const bool last = (t == nt - 2);
            const char* a1 = cA + (size_t)(t + 1) * kstep;
            const char* a2 = last ? nA : cA + (size_t)(t + 2) * kstep; const char* b2 = last ? nB : cB + (size_t)(t + 2) * kstep;
            const char* a3 = a2 + kstep; const char* b3 = b2 + kstep;
            if (last && has_next) S.a_ready(nxt);
            if constexpr (SP2) {
            PG8_LDB(B0, 0, 0); PG8_LDB(B1, 0, 1); PG8_SCHED; PG8_LDA(At, 0, 0); PG8_STAGE(PG8_SA(1, 1), a1 + hstep, voffA);
            PG8_WAIT_V(8); PG8_WAIT_L(0); PG8_BAR; PG8_MMA(0, 0, At, B0); PG8_MMA(0, 1, At, B1); PG8_BAR; PG8_SCHED;
            PG8_LDA(At, 0, 1); PG8_STAGE(PG8_SB(0, 0), b2, voffB); PG8_STAGE(PG8_SB(0, 1), b2 + hstep, voffB); PG8_STAGE(PG8_SA(0, 0), a2, voffA);
            PG8_WAIT_V(8); PG8_WAIT_L(0); PG8_BAR; PG8_MMA(1, 0, At, B0); PG8_MMA(1, 1, At, B1); PG8_BAR; PG8_SCHED;
            PG8_LDB(B0, 1, 0); PG8_LDB(B1, 1, 1); PG8_SCHED; PG8_LDA(At, 1, 0); PG8_STAGE(PG8_SA(0, 1), a2 + hstep, voffA);
            PG8_WAIT_V(8); PG8_WAIT_L(0); PG8_BAR; PG8_MMA(0, 0, At, B0); PG8_MMA(0, 1, At, B1); PG8_BAR; PG8_SCHED;
            PG8_LDA(At, 1, 1); PG8_STAGE(PG8_SB(1, 0), b3, voffB); PG8_STAGE(PG8_SB(1, 1), b3 + hstep, voffB); PG8_STAGE(PG8_SA(1, 0), a3, voffA);
            PG8_WAIT_V(8); PG8_WAIT_L(0); PG8_BAR; PG8_MMA(1, 0, At, B0); PG8_MMA(1, 1, At, B1); PG8_BAR; PG8_SCHED;
            } else {
            PG8_LDB(B0, 0, 0); PG8_SCHED; PG8_LDA(At, 0, 0); PG8_STAGE(PG8_SA(1, 1), a1 + hstep, voffA);
            PG8_WAIT_L(8); PG8_BAR; PG8_WAIT_L(0); PG8_MMA(0, 0, At, B0); PG8_BAR; PG8_SCHED;
            PG8_LDB(B1, 0, 1); PG8_STAGE(PG8_SB(0, 0), b2, voffB);
            PG8_BAR; PG8_WAIT_L(0); PG8_MMA(0, 1, At, B1); PG8_BAR;
            PG8_LDA(At, 0, 1); PG8_STAGE(PG8_SA(0, 0), a2, voffA);
            PG8_BAR; PG8_WAIT_L(0); PG8_MMA(1, 0, At, B0); PG8_BAR; PG8_SCHED;
            PG8_STAGE(PG8_SB(0, 1), b2 + hstep, voffB);
            PG8_WAIT_V(6); PG8_BAR; PG8_MMA(1, 1, At, B1); PG8_BAR;
            PG8_LDB(B0, 1, 0); PG8_SCHED; PG8_LDA(At, 1, 0); PG8_STAGE(PG8_SA(0, 1), a2 + hstep, voffA);
            PG8_WAIT_L(8); PG8_BAR; PG8_WAIT_L(0); PG8_MMA(0, 0, At, B0); PG8_BAR; PG8_SCHED;
            PG8_LDB(B1, 1, 1); PG8_STAGE(PG8_SB(1, 0), b3, voffB);
            PG8_BAR; PG8_WAIT_L(0); PG8_MMA(0, 1, At, B1); PG8_BAR;
            PG8_LDA(At, 1, 1); PG8_STAGE(PG8_SA(1, 0), a3, voffA);
            PG8_BAR; PG8_WAIT_L(0); PG8_MMA(1, 0, At, B0); PG8_BAR; PG8_SCHED;
            PG8_STAGE(PG8_SB(1, 1), b3 + hstep, voffB);
            PG8_WAIT_V(6); PG8_BAR; PG8_MMA(1, 1, At, B1); PG8_BAR;
            }
        }
        if constexpr (ALIGN_EPI) { if (wr == 0) PG8_BAR; }
        if constexpr (!Epi::AFTER_DRAIN) { E(acc, cur, wr, wc, fr, fq); S.done(cur); }
        if (!has_next) break;
#pragma unroll
        for (int a = 0; a < 2; ++a)
#pragma unroll
            for (int b = 0; b < 2; ++b)
#pragma unroll
                for (int m = 0; m < 4; ++m)
#pragma unroll
                    for (int n = 0; n < 2; ++n) acc[a][b][m][n] = (f32x4){0.f, 0.f, 0.f, 0.f};
        cur = nxt; cA = nA; cB = nB; ++ui;
        if constexpr (ALIGN_EPI) { if (wr == 1) PG8_BAR; }
    }
    PG8_WAIT_V(0);
    if constexpr (!ALIGN_EPI) { if (wr == 0) PG8_BAR; }
    PG8_BAR;
    if constexpr (Epi::AFTER_DRAIN) { E.fused(acc, cur, wr, wc, fr, fq, lds, wid, lane); S.done(cur); }
#undef PG8_SA
#undef PG8_SB
#undef PG8_STAGE
#undef PG8_LDA
#undef PG8_LDB
#undef PG8_MMA
#undef PG8_WAIT_V
#undef PG8_WAIT_L
#undef PG8_BAR
#undef PG8_SCHED
}
}
#define LAS __attribute__((address_space(3)))
#define GAS __attribute__((address_space(1)))
typedef unsigned short bf16_t;
typedef unsigned v4u __attribute__((ext_vector_type(4)));
typedef unsigned v2u __attribute__((ext_vector_type(2)));
typedef float f32x4 __attribute__((ext_vector_type(4)));
typedef short bf16x8 __attribute__((ext_vector_type(8)));
constexpr int NWAVES = 8, NTHR = 512;
constexpr int DM = 1024, SEQ = 2048, NGRP = 3, BG = 8, MG = BG * SEQ;
constexpr int INW = 7184, NIN = 7168, DFF = 2816, NUP = 2 * DFF, NMEM = 256, MEMR = BG * NMEM;
constexpr float ALPHA = 1.18920711500272f, LN_EPS = 1e-5f;
constexpr size_t MiB = 1u << 20;
constexpr size_t WS_WIN = 1 * MiB, WS_WG = 15 * MiB, WS_WMEM = 16 * MiB, WS_WBM = 18 * MiB, WS_WBA = 19 * MiB, WS_WBC = 21 * MiB, WS_WOUT = 22 * MiB, WS_WUP = 24 * MiB, WS_WDN = 35 * MiB;
constexpr size_t WS_MEMB = 41 * MiB, WS_STATS = 53 * MiB, WS_XN = 54 * MiB;
constexpr size_t WS_QKM = 86 * MiB, WS_VM = 118 * MiB, WS_OM = 134 * MiB, WS_QA = 150 * MiB, WS_KA = 182 * MiB, WS_VA = 190 * MiB, WS_QC = 198 * MiB, WS_GBR = 214 * MiB, WS_GT = 310 * MiB;
constexpr size_t WS_KC = 311 * MiB, WS_VC = 313 * MiB, WS_CT = 315 * MiB, WS_NP = 347 * MiB, WS_MERGED = 348 * MiB, WS_SCR = 380 * MiB, WS_END = 444 * MiB;
constexpr size_t WS_U1 = 86 * MiB, WS_U2 = 174 * MiB, WS_HID = 262 * MiB;
constexpr int LDS_BYTES = 147456, RING_BYTES = 131072, BAR_LDS_OFF = 147456 - 64;
constexpr size_t WS_CTL = 0, WS_ROPE = 65536;
struct Args { const float* in[26]; float* out; unsigned char* ws; };

__device__ __forceinline__ float wave_sum(float v) {
#pragma unroll
    for (int o = 1; o < 64; o <<= 1) v += __shfl_xor(v, o);
    return v;
}
__device__ __forceinline__ unsigned pk2(float lo, float hi) { return pg8::cvt_pk_bf16(lo, hi); }
__device__ __forceinline__ float bflo(unsigned w) { return __uint_as_float(w << 16); }
__device__ __forceinline__ float bfhi(unsigned w) { return __uint_as_float(w & 0xffff0000u); }
#define LDS_WAIT() asm volatile("s_waitcnt lgkmcnt(0)" ::: "memory")

__device__ __forceinline__ void transpose_item(const float* W, int Nsrc, int K, bf16_t* WT, int k0, int n0dst, int n0src, LAS float* scr, int lane) {
#pragma unroll 8
    for (int i = 0; i < 32; ++i) { const int kk = 2 * i + (lane >> 5); scr[kk * 33 + (lane & 31)] = ((const GAS float*)W)[(size_t)(k0 + kk) * Nsrc + n0src + (lane & 31)]; }
    LDS_WAIT(); asm volatile("" ::: "memory");
    const int c = lane & 7;
#pragma unroll
    for (int j = 0; j < 4; ++j) { const int n = (lane >> 3) + 8 * j; const LAS float* s = scr + (8 * c) * 33 + n;
        v4u o; o.x = pk2(s[0 * 33], s[1 * 33]); o.y = pk2(s[2 * 33], s[3 * 33]); o.z = pk2(s[4 * 33], s[5 * 33]); o.w = pk2(s[6 * 33], s[7 * 33]);
        *(GAS v4u*)(WT + (size_t)(n0dst + n) * K + k0 + 8 * c) = o; }
    LDS_WAIT(); asm volatile("" ::: "memory");
}
__device__ __forceinline__ void ln_row(const float* src, const float* g, const float* b, float* of32, bf16_t* obf, float* stats, int lane) {
    const GAS f32x4* xr = (const GAS f32x4*)src + lane;
    f32x4 v[4]; float s = 0.f;
#pragma unroll
    for (int j = 0; j < 4; ++j) { v[j] = xr[64 * j]; s += (v[j].x + v[j].y) + (v[j].z + v[j].w); }
    const float mean = wave_sum(s) * (1.f / DM); float s2 = 0.f;
#pragma unroll
    for (int j = 0; j < 4; ++j) { v[j] = v[j] - mean; s2 += (v[j].x * v[j].x + v[j].y * v[j].y) + (v[j].z * v[j].z + v[j].w * v[j].w); }
    const float rstd = 1.f / sqrtf(wave_sum(s2) * (1.f / DM) + LN_EPS);
    if (stats && lane == 0) { stats[0] = mean; stats[1] = rstd; }
#pragma unroll
    for (int j = 0; j < 4; ++j) { const f32x4 gv = ((const GAS f32x4*)g)[lane + 64 * j], bv = ((const GAS f32x4*)b)[lane + 64 * j];
        const f32x4 o = v[j] * rstd * gv + bv;
        if (of32) ((GAS f32x4*)of32)[lane + 64 * j] = o;
        if (obf) { v2u w; w.x = pk2(o.x, o.y); w.y = pk2(o.z, o.w); ((GAS v2u*)obf)[lane + 64 * j] = w; } }
}
__device__ __forceinline__ float gelu_tanh(float x) {
    const float u = 0.7978845608028654f * (x + 0.044715f * x * x * x);
    const float e = __expf(2.f * u);
    const float th = 1.f - 2.f * __builtin_amdgcn_rcpf(e + 1.f);
    return 0.5f * x * (1.f + th);
}
#define XB_TMO      128
#define XB_XCNT(j)  (256  + 64 * (j))
#define XB_XSUB(j)  (1280 + 64 * (j))
#define XB_XGEN(j)  (2304 + 64 * (j))
#define XB_TOP      3328
#define XB_TOPGEN   3392
#define XCD_BAR_WORDS 3456
#define XB_SPIN_CAP (1u << 18)

__device__ __forceinline__ unsigned xb_ld(unsigned* p)              { return __hip_atomic_load(p, __ATOMIC_RELAXED, __HIP_MEMORY_SCOPE_AGENT); }
__device__ __forceinline__ unsigned xb_add(unsigned* p, unsigned v) { return __hip_atomic_fetch_add(p, v, __ATOMIC_RELAXED, __HIP_MEMORY_SCOPE_AGENT); }
__device__ __forceinline__ unsigned xb_xcc_id() { return (unsigned)__builtin_amdgcn_s_getreg((3 << 11) | 20) & 0xFu; }
#define XB_SPIN(cond, bar) do { unsigned _sp = 0; while (cond) { __builtin_amdgcn_s_sleep(1); \
    if ((++_sp & 255u) == 0u) { if (xb_ld(&(bar)[XB_TMO])) break; if (_sp > XB_SPIN_CAP) { atomicAdd(&(bar)[XB_TMO], 1u); break; } } } } while (0)

struct XcdBarrier {
    unsigned* bar; unsigned x;
    volatile LAS unsigned* st;
};

__device__ __forceinline__ XcdBarrier xcd_barrier_post(unsigned* bar, volatile LAS unsigned* st) {
    XcdBarrier b; b.bar = bar; b.x = xb_xcc_id(); b.st = st;
    if (threadIdx.x == 0) (void)xb_add(&bar[XB_XCNT(b.x)], 1u);
    return b;
}
__device__ __forceinline__ void xcd_barrier_complete(unsigned* bar, unsigned x, unsigned& nloc, unsigned& nx) {
    const unsigned G = gridDim.x * gridDim.y * gridDim.z;
    unsigned sum, cnt, mine, sp = 0u;
    for (;;) {
        sum = 0u; cnt = 0u; mine = 0u;
#pragma unroll
        for (unsigned j = 0; j < 16; ++j) { const unsigned c = xb_ld(&bar[XB_XCNT(j)]); sum += c; cnt += (c > 0u) ? 1u : 0u; mine = (j == x) ? c : mine; }
        if (sum == G) break;
        __builtin_amdgcn_s_sleep(1);
        if ((++sp & 255u) == 0u) { if (xb_ld(&bar[XB_TMO])) break; if (sp > XB_SPIN_CAP) { atomicAdd(&bar[XB_TMO], 1u); break; } }
    }
    nloc = mine > 0u ? mine : 1u; nx = cnt > 0u ? cnt : 1u;
}

__device__ __forceinline__ void xcd_barrier(const XcdBarrier& b) {
    asm volatile("s_waitcnt vmcnt(0)" ::: "memory");
    __syncthreads();
    if (threadIdx.x == 0) {
        unsigned* bar = b.bar;
        __builtin_amdgcn_s_waitcnt(0);
        unsigned nloc = b.st[0], nx = b.st[1];
        if (nloc == 0u) { xcd_barrier_complete(bar, b.x, nloc, nx); b.st[0] = nloc; b.st[1] = nx; }
        const unsigned old = xb_add(&bar[XB_XSUB(b.x)], 1u);
        const unsigned gen = old / nloc;
        if (old + 1u == (gen + 1u) * nloc) {
            __builtin_amdgcn_fence(__ATOMIC_RELEASE, "agent");
            asm volatile("s_waitcnt vmcnt(0)" ::: "memory");
            const unsigned og = xb_add(&bar[XB_TOP], 1u);
            const unsigned tg = og / nx;
            if (og + 1u == (tg + 1u) * nx) xb_add(&bar[XB_TOPGEN], 1u);
            else XB_SPIN(xb_ld(&bar[XB_TOPGEN]) == tg, bar);
            __builtin_amdgcn_fence(__ATOMIC_ACQUIRE, "agent");
            xb_add(&bar[XB_XGEN(b.x)], 1u);
            asm volatile("s_waitcnt vmcnt(0)" ::: "memory");
        } else {
            XB_SPIN(xb_ld(&bar[XB_XGEN(b.x)]) == gen, bar);
            __builtin_amdgcn_fence(__ATOMIC_ACQUIRE, "agent");
            asm volatile("s_waitcnt vmcnt(0)" ::: "memory");
        }
    }
    __syncthreads();
}
namespace att {
using bf16 = unsigned short;
constexpr int   D = 128, NW = 8, QBLK = 32, KVBLK = 64;
constexpr float SCALE = 0.088388347648318440f;
constexpr float THR = 8.f;
constexpr int SDEPTH = 2;
constexpr size_t SHM_V = KVBLK * D * 2, SHM_K = KVBLK * D * 2, SHM_ATTN = 2 * SHM_V + 2 * SHM_K + NW * 64 * 4;
using bf16x8 = __attribute__((ext_vector_type(8))) short;
using s16x4  = __attribute__((ext_vector_type(4))) short;
using f32x16 = __attribute__((ext_vector_type(16))) float;
using f32x8  = __attribute__((ext_vector_type(8))) float;
using u32x4  = __attribute__((ext_vector_type(4))) unsigned;
#define KSWZ(row, colB) ((row) * 256 + ((colB) ^ (((row) & 7) << 4)))
#define SBAR() __builtin_amdgcn_sched_barrier(0)
__device__ __forceinline__ int crow(int r, int hi) { return (r & 3) + 8 * (r >> 2) + 4 * hi; }
__device__ __forceinline__ unsigned cvtpk(float lo, float hi) {
  unsigned r; asm volatile("v_cvt_pk_bf16_f32 %0, %1, %2" : "=v"(r) : "v"(lo), "v"(hi)); return r;
}
template <typename TIn> struct Stage;
template <> struct Stage<bf16>  { using T = bf16x8;
  __device__ static __forceinline__ T ld8(const bf16* p) { return *reinterpret_cast<const bf16x8*>(p); }
  __device__ static __forceinline__ bf16x8 tobf(T x) { return x; } };
template <> struct Stage<float> { using T = f32x8;
  __device__ static __forceinline__ T ld8(const float* p) { return *reinterpret_cast<const f32x8*>(p); }
  __device__ static __forceinline__ bf16x8 tobf(T x) {
    u32x4 w = {cvtpk(x[0], x[1]), cvtpk(x[2], x[3]), cvtpk(x[4], x[5]), cvtpk(x[6], x[7])}; return *reinterpret_cast<bf16x8*>(&w); } };

__device__ __forceinline__ void partialSM(f32x16& p0, f32x16& p1, float& m_reg, float& mn, float& alpha) {
  constexpr float C = SCALE * 1.4426950408889634f;
  float pmax = p0[0]; for (int r = 1; r < 16; ++r) pmax = fmaxf(pmax, p0[r]); for (int r = 0; r < 16; ++r) pmax = fmaxf(pmax, p1[r]);
  { auto rr = __builtin_amdgcn_permlane32_swap(__float_as_uint(pmax), __float_as_uint(pmax), false, false);
    pmax = fmaxf(__uint_as_float(rr[0]), __uint_as_float(rr[1])); }
  if (__builtin_expect(__all(pmax - m_reg <= THR / SCALE), 1)) { mn = m_reg; alpha = 1.f; }
  else { mn = fmaxf(m_reg, pmax); alpha = __builtin_amdgcn_exp2f((m_reg - mn) * C); m_reg = mn; }
  float mnC = -mn * C;
  for (int r = 0; r < 16; ++r) p0[r] = fmaf(p0[r], C, mnC); for (int r = 0; r < 16; ++r) p1[r] = fmaf(p1[r], C, mnC);
  for (int r = 0; r < 16; ++r) p0[r] = __builtin_amdgcn_exp2f(p0[r]);
}
__device__ __forceinline__ void finishSM(f32x16& p0, f32x16& p1, float alpha, float& l_reg, bf16x8& pa0, bf16x8& pa1, bf16x8& pa2, bf16x8& pa3) {
  for (int r = 0; r < 16; ++r) p1[r] = __builtin_amdgcn_exp2f(p1[r]);
  float ps = 0; for (int r = 0; r < 16; ++r) ps += p0[r]; for (int r = 0; r < 16; ++r) ps += p1[r];
  { auto rr = __builtin_amdgcn_permlane32_swap(__float_as_uint(ps), __float_as_uint(ps), false, false);
    ps = __uint_as_float(rr[0]) + __uint_as_float(rr[1]); }
  l_reg = l_reg * alpha + ps;
#define PK4(P, BASE, OUT) do { unsigned a0 = cvtpk(P[BASE + 0], P[BASE + 1]), a1 = cvtpk(P[BASE + 2], P[BASE + 3]);   \
    unsigned b0 = cvtpk(P[BASE + 4], P[BASE + 5]), b1 = cvtpk(P[BASE + 6], P[BASE + 7]);                              \
    auto r0 = __builtin_amdgcn_permlane32_swap(a0, b0, false, false); auto r1 = __builtin_amdgcn_permlane32_swap(a1, b1, false, false); \
    u32x4 w = {r0[0], r1[0], r0[1], r1[1]}; OUT = *reinterpret_cast<bf16x8*>(&w); } while (0)
  PK4(p0, 0, pa0); PK4(p0, 8, pa1); PK4(p1, 0, pa2); PK4(p1, 8, pa3);
#undef PK4
}
__device__ __forceinline__ void qkt(f32x16& p0, f32x16& p1, const bf16* Ks, const bf16x8* qr, int r32, int hi) {
  p0 = f32x16{}; p1 = f32x16{};
  for (int d0 = 0; d0 < 8; ++d0) { int cb = (d0 * 16 + hi * 8) * 2;
    bf16x8 b0 = *reinterpret_cast<const bf16x8*>((const char*)Ks + KSWZ(r32, cb));
    bf16x8 b1 = *reinterpret_cast<const bf16x8*>((const char*)Ks + KSWZ(32 + r32, cb));
    p0 = __builtin_amdgcn_mfma_f32_32x32x16_bf16(b0, qr[d0], p0, 0, 0, 0);
    p1 = __builtin_amdgcn_mfma_f32_32x32x16_bf16(b1, qr[d0], p1, 0, 0, 0); }
}
__device__ __forceinline__ int v_st(int k, int c) { const int kk = (k & ~0xC) | ((k & 4) << 1) | ((k & 8) >> 1); return ((kk >> 3) * 4 + (c >> 5)) * 512 + ((kk & 7) * 32 + (c & 31)) * 2; }
__device__ __forceinline__ int v_rd_base(int lane) { return ((lane & 3) << 3) | (((lane >> 2) & 3) << 6) | (((lane >> 4) & 1) << 5) | (((lane >> 5) & 1) << 8); }
constexpr int v_rd_off(int d0, int ks, int half) { return d0 * 512 + ks * 4096 + half * 2048; }
template <int OFF> __device__ __forceinline__ s16x4 tr_read(int vb) {
  s16x4 r; asm volatile("ds_read_b64_tr_b16 %0, %1 offset:%2" : "=&v"(r) : "v"(vb), "i"(OFF) : "memory"); return r;
}
template <int D0> __device__ __forceinline__ void pv_one(f32x16& od, int vb, bf16x8 pa0, bf16x8 pa1, bf16x8 pa2, bf16x8 pa3) {
  const s16x4 l0 = tr_read<v_rd_off(D0, 0, 0)>(vb), h0 = tr_read<v_rd_off(D0, 0, 1)>(vb), l1 = tr_read<v_rd_off(D0, 1, 0)>(vb), h1 = tr_read<v_rd_off(D0, 1, 1)>(vb);
  const s16x4 l2 = tr_read<v_rd_off(D0, 2, 0)>(vb), h2 = tr_read<v_rd_off(D0, 2, 1)>(vb), l3 = tr_read<v_rd_off(D0, 3, 0)>(vb), h3 = tr_read<v_rd_off(D0, 3, 1)>(vb);
  asm volatile("s_waitcnt lgkmcnt(0)" ::: "memory"); SBAR();
#define PK(L, H) (bf16x8){L[0], L[1], L[2], L[3], H[0], H[1], H[2], H[3]}
  od = __builtin_amdgcn_mfma_f32_32x32x16_bf16(pa0, PK(l0, h0), od, 0, 0, 0);
  od = __builtin_amdgcn_mfma_f32_32x32x16_bf16(pa1, PK(l1, h1), od, 0, 0, 0);
  od = __builtin_amdgcn_mfma_f32_32x32x16_bf16(pa2, PK(l2, h2), od, 0, 0, 0);
  od = __builtin_amdgcn_mfma_f32_32x32x16_bf16(pa3, PK(l3, h3), od, 0, 0, 0);
#undef PK
}
__device__ __forceinline__ void pv_d0(f32x16* o, int vb, bf16x8 pa0, bf16x8 pa1, bf16x8 pa2, bf16x8 pa3) {
  pv_one<0>(o[0], vb, pa0, pa1, pa2, pa3); pv_one<1>(o[1], vb, pa0, pa1, pa2, pa3); pv_one<2>(o[2], vb, pa0, pa1, pa2, pa3); pv_one<3>(o[3], vb, pa0, pa1, pa2, pa3);
}

template <int LDQ, int LDK>
__device__ __forceinline__ void attn_dense_body(const bf16* Qb, const bf16* __restrict__ Kh, const bf16* __restrict__ Vh,
                                                bf16* Ob, int seq, char* lds) {
  constexpr int LDO = LDQ; using TQ = bf16; using St = Stage<bf16>; using SQ = Stage<TQ>;
  int tid_ = threadIdx.x; asm volatile("" : "+v"(tid_));
  const int tid = tid_, wid = tid >> 6, lane = tid & 63, r32 = lane & 31, hi = lane >> 5;
  bf16* V_lds = (bf16*)lds; bf16* K_lds = (bf16*)(lds + 2 * SHM_V);
  float* ws = (float*)(lds + 2 * SHM_V + 2 * SHM_K) + wid * 64; float* li_l = ws; float* al_l = ws + 32;
  float m_reg = -1e30f, l_reg = 0; f32x16 o[4] = {}; bf16x8 qr[8];
  const TQ* Qw = Qb + (long)(wid * QBLK + r32) * LDQ + hi * 8;
#pragma unroll
  for (int d0 = 0; d0 < 8; ++d0) qr[d0] = SQ::tobf(SQ::ld8(Qw + d0 * 16));
  const int sr = tid >> 4, sc = (tid & 15) * 8, vst0 = v_st(sr, sc), vst1 = v_st(32 + sr, sc);
  const int vb0 = (int)(uintptr_t)V_lds + v_rd_base(lane);
  struct { typename St::T vs0, vs1, ks0, ks1; } sr_[SDEPTH];
#define SLOAD(i, k0) do { sr_[i].vs0 = St::ld8(&Vh[(long)((k0) + sr) * LDK + sc]); sr_[i].vs1 = St::ld8(&Vh[(long)((k0) + 32 + sr) * LDK + sc]); \
    sr_[i].ks0 = St::ld8(&Kh[(long)((k0) + sr) * LDK + sc]); sr_[i].ks1 = St::ld8(&Kh[(long)((k0) + 32 + sr) * LDK + sc]); } while (0)
#define SWRITE(b, i) do { *(bf16x8*)((char*)V_lds + (b) * SHM_V + vst0) = St::tobf(sr_[i].vs0);          \
    *(bf16x8*)((char*)V_lds + (b) * SHM_V + vst1) = St::tobf(sr_[i].vs1); int kc = sc * 2;               \
    *(bf16x8*)((char*)K_lds + (b) * SHM_K + KSWZ(sr, kc)) = St::tobf(sr_[i].ks0);                       \
    *(bf16x8*)((char*)K_lds + (b) * SHM_K + KSWZ(32 + sr, kc)) = St::tobf(sr_[i].ks1); } while (0)
#define SWAIT() do { if constexpr (SDEPTH == 2) asm volatile("s_waitcnt vmcnt(4)" ::: "memory"); else asm volatile("s_waitcnt vmcnt(0)" ::: "memory"); } while (0)
#define RESC(a) do { if (__any((a) < 1.f)) { if (hi == 0) al_l[r32] = (a); asm volatile("s_waitcnt lgkmcnt(0)" ::: "memory"); \
    for (int d = 0; d < 4; ++d) for (int r = 0; r < 16; ++r) o[d][r] *= al_l[crow(r, hi)]; } } while (0)
  f32x16 pA0, pA1, pB0, pB1; float mnA, mnB, alA, alB; bf16x8 pa0, pa1, pa2, pa3; const int NT = seq / KVBLK;
  constexpr int SE = 0, SO = SDEPTH - 1;
  SLOAD(SE, 0); asm volatile("s_waitcnt vmcnt(0)" ::: "memory"); SWRITE(0, SE); __syncthreads();
  qkt(pA0, pA1, K_lds, qr, r32, hi); partialSM(pA0, pA1, m_reg, mnA, alA);
  SLOAD(SO, KVBLK); if constexpr (SDEPTH == 2) { if (2 < NT) SLOAD(SE, 2 * KVBLK); }
  SWAIT(); SWRITE(1, SO); __syncthreads();
  for (int j = 1; j + 1 < NT; j += 2) {
    SBAR(); qkt(pB0, pB1, (bf16*)((char*)K_lds + SHM_K), qr, r32, hi);
    finishSM(pA0, pA1, alA, l_reg, pa0, pa1, pa2, pa3); SBAR();
    SLOAD(SO, (j + SDEPTH) * KVBLK); SBAR();
    pv_d0(o, vb0, pa0, pa1, pa2, pa3); partialSM(pB0, pB1, m_reg, mnB, alB);
    __syncthreads(); SWAIT(); SWRITE(0, SE);
    RESC(alB); __syncthreads();
    SBAR(); qkt(pA0, pA1, K_lds, qr, r32, hi);
    finishSM(pB0, pB1, alB, l_reg, pa0, pa1, pa2, pa3); SBAR();
    if (SDEPTH == 1 || j + 3 < NT) SLOAD(SE, (j + 1 + SDEPTH) * KVBLK); SBAR();
    pv_d0(o, vb0 + (int)SHM_V, pa0, pa1, pa2, pa3); partialSM(pA0, pA1, m_reg, mnA, alA);
    __syncthreads(); SWAIT(); SWRITE(1, SO);
    RESC(alA); __syncthreads();
  }
  SBAR(); qkt(pB0, pB1, (bf16*)((char*)K_lds + SHM_K), qr, r32, hi);
  finishSM(pA0, pA1, alA, l_reg, pa0, pa1, pa2, pa3); SBAR();
  pv_d0(o, vb0, pa0, pa1, pa2, pa3); partialSM(pB0, pB1, m_reg, mnB, alB);
  __syncthreads(); RESC(alB);
  finishSM(pB0, pB1, alB, l_reg, pa0, pa1, pa2, pa3); SBAR();
  pv_d0(o, vb0 + (int)SHM_V, pa0, pa1, pa2, pa3);
  if (hi == 0) li_l[r32] = l_reg; asm volatile("s_waitcnt lgkmcnt(0)" ::: "memory");
  float rli[16];
#pragma unroll
  for (int r = 0; r < 16; ++r) rli[r] = __builtin_amdgcn_rcpf(li_l[crow(r, hi)]);
  bf16* Ow = Ob + (long)(wid * QBLK) * LDO;
#pragma unroll
  for (int r = 0; r < 16; ++r) { int orow = crow(r, hi);
    for (int d0 = 0; d0 < 4; ++d0) Ow[(long)orow * LDO + d0 * 32 + r32] = (bf16)(cvtpk(o[d0][r] * rli[r], 0.f) & 0xffffu); }
  __syncthreads();
#undef SLOAD
#undef SWRITE
#undef SWAIT
#undef RESC
}

}
namespace ml {
using att::bf16x8; using att::s16x4; using att::f32x16; using att::u32x4;
constexpr float DKS = 0.08838834764831845f;
constexpr int ML_KT = 0, ML_VT = 32768, ML_WA = 65536, ML_SM = 73728;
constexpr int M3_K = 0, M3_V = 32768, M3_CF = 65536, M3_CB = 98304, M3_X = 131072;
__device__ __forceinline__ float wscan_add(float v, int lane) {
#pragma unroll
    for (int o = 1; o < 64; o <<= 1) { const float t = __shfl_up(v, o); if (lane >= o) v += t; }
    return v; }
__device__ __forceinline__ float wscan_max(float v, int lane) {
#pragma unroll
    for (int o = 1; o < 64; o <<= 1) { const float t = __shfl_up(v, o); if (lane >= o) v = fmaxf(v, t); }
    return v; }
__device__ __forceinline__ float wrscan_max(float v, int lane) {
#pragma unroll
    for (int o = 1; o < 64; o <<= 1) { const float t = __shfl_down(v, o); if (lane + o < 64) v = fmaxf(v, t); }
    return v; }
__device__ __forceinline__ float wave_max(float v) {
#pragma unroll
    for (int o = 1; o < 64; o <<= 1) v = fmaxf(v, __shfl_xor(v, o));
    return v; }
__device__ __forceinline__ float logsig(float f) { return fminf(f, 0.f) - log1pf(expf(-fabsf(f))); }
__device__ __forceinline__ void conv_silu8(const bf16_t* p, int t, const float (&w)[3][8], const float (&b)[8], float (&o)[8]) {
    const v4u z = {0u, 0u, 0u, 0u};
    const v4u c = *(const GAS v4u*)p;
    const v4u a = (t > 0) ? *(const GAS v4u*)(p - 1024) : z;
    const v4u n = (t < SEQ - 1) ? *(const GAS v4u*)(p + 1024) : z;
#pragma unroll
    for (int q = 0; q < 4; ++q) {
        const float yl = w[0][2 * q] * bflo(a[q]) + w[1][2 * q] * bflo(c[q]) + w[2][2 * q] * bflo(n[q]) + b[2 * q];
        const float yh = w[0][2 * q + 1] * bfhi(a[q]) + w[1][2 * q + 1] * bfhi(c[q]) + w[2][2 * q + 1] * bfhi(n[q]) + b[2 * q + 1];
        o[2 * q] = yl * pg8::sigm(yl); o[2 * q + 1] = yh * pg8::sigm(yh); }
}
__device__ __forceinline__ void ld_convw(const float* cw, const float* cb, int col, float (&w)[3][8], float (&b)[8]) {
#pragma unroll
    for (int j = 0; j < 3; ++j)
#pragma unroll
        for (int e = 0; e < 8; ++e) w[j][e] = cw[j * 1024 + col + e];
#pragma unroll
    for (int e = 0; e < 8; ++e) b[e] = cb[col + e];
}
__device__ __forceinline__ bf16x8 pack8(const float (&o)[8], float s) {
    u32x4 w = {att::cvtpk(o[0] * s, o[1] * s), att::cvtpk(o[2] * s, o[3] * s), att::cvtpk(o[4] * s, o[5] * s), att::cvtpk(o[6] * s, o[7] * s)};
    return *reinterpret_cast<bf16x8*>(&w); }
#define ML_PK(L, H) (bf16x8){L[0], L[1], L[2], L[3], H[0], H[1], H[2], H[3]}

__device__ __forceinline__ void scan_item(const bf16_t* QKM, const bf16_t* VM, const float* GT, const float* cw, const float* cb, bf16_t* CT, float* NP, float* MP,
                                          int b, int h, int dir, char* lds) {
    int tid_ = threadIdx.x; asm volatile("" : "+v"(tid_));
    const int tid = tid_, wid = tid >> 6, lane = tid & 63, hi = lane >> 5;
    float* WA = (float*)(lds + ML_WA); float* SM = (float*)(lds + ML_SM);
#pragma unroll
    for (int cc = 0; cc < 2; ++cc) {
        const int c = 2 * wid + cc, s0 = 128 * c + 2 * lane; const float* gp = GT + (size_t)(b * SEQ + s0) * 16 + 8 * dir + h;
        const float li0 = gp[0], li1 = gp[16], lf0 = logsig(gp[4]), lf1 = logsig(gp[20]);
        const float s = lf0 + lf1, incl = wscan_add(s, lane), bl1 = incl, bl0 = incl - lf1, gtot = __shfl(incl, 63);
        float a0, a1;
        if (dir == 0) { a0 = gtot - bl0 + li0; a1 = gtot - bl1 + li1; } else { a0 = bl0 - lf0 + li0; a1 = bl1 - lf1 + li1; }
        const float ma = wave_max(fmaxf(a0, a1));
        WA[s0] = expf(a0 - ma); WA[s0 + 1] = expf(a1 - ma);
        if (lane == 0) { SM[c] = gtot; SM[16 + c] = ma; }
    }
    __syncthreads();
    if (tid == 0) { float m = 0.f;
        for (int k = 0; k < 16; ++k) { const int c = dir ? 15 - k : k; const float gc = SM[c], ma = SM[16 + c], mn = fmaxf(gc + m, ma);
            SM[64 + c] = m; SM[32 + c] = expf(gc + m - mn); SM[48 + c] = expf(ma - mn); m = mn; } }
    __syncthreads();
    const int a = wid >> 1, dbase = 2 * (wid & 1);
    f32x16 acc0 = {}, acc1 = {}, nacc = {};
    const int sr = tid >> 4, sc = (tid & 15) * 8, vst0 = att::v_st(sr, sc), vst1 = att::v_st(32 + sr, sc);
    const int lbase = (int)(uintptr_t)lds;
    const int vbK = lbase + ML_KT + att::v_rd_base(lane) + a * 512, vbV = lbase + ML_VT + att::v_rd_base(lane) + dbase * 512;
    float w[3][8], bb[8]; ld_convw(cw, cb, 512 + h * 128 + sc, w, bb);
    const bf16x8 ones = {0x3F80, 0x3F80, 0x3F80, 0x3F80, 0x3F80, 0x3F80, 0x3F80, 0x3F80};
    const size_t idx0 = (size_t)((b * 4 + h) * 2 + dir) * 16;
    for (int k = 0; k < 16; ++k) {
        const int c = dir ? 15 - k : k; const size_t idx = idx0 + c;
        { bf16_t* ct = CT + idx * 16384; const int cl = lane & 31;
#pragma unroll
          for (int q = 0; q < 4; ++q) { const int dk = 32 * a + 8 * q + 4 * hi;
              v2u o0; o0.x = att::cvtpk(acc0[4 * q], acc0[4 * q + 1]); o0.y = att::cvtpk(acc0[4 * q + 2], acc0[4 * q + 3]);
              v2u o1; o1.x = att::cvtpk(acc1[4 * q], acc1[4 * q + 1]); o1.y = att::cvtpk(acc1[4 * q + 2], acc1[4 * q + 3]);
              *(GAS v2u*)(ct + (32 * dbase + cl) * 128 + dk) = o0; *(GAS v2u*)(ct + (32 * (dbase + 1) + cl) * 128 + dk) = o1; }
          if (dbase == 0 && cl == 0) {
#pragma unroll
              for (int r = 0; r < 16; ++r) NP[idx * 128 + 32 * a + att::crow(r, hi)] = nacc[r]; }
          if (tid == 0) MP[idx] = SM[64 + c]; }
        { const float sp = SM[32 + c];
#pragma unroll
          for (int r = 0; r < 16; ++r) { acc0[r] *= sp; acc1[r] *= sp; nacc[r] *= sp; } }
        { const float scs = SM[48 + c] * DKS;
#pragma unroll
          for (int tl = 0; tl < 2; ++tl)
#pragma unroll
              for (int hf = 0; hf < 2; ++hf) { const int sl = 64 * tl + 32 * hf + sr, t = 128 * c + sl; const size_t row = (size_t)b * SEQ + t;
                  float o[8]; conv_silu8(QKM + row * 1024 + 512 + h * 128 + sc, t, w, bb, o);
                  *(bf16x8*)(lds + ML_KT + tl * 16384 + (hf ? vst1 : vst0)) = pack8(o, scs * WA[t]);
                  *(bf16x8*)(lds + ML_VT + tl * 16384 + (hf ? vst1 : vst0)) = *(const GAS bf16x8*)(VM + row * 512 + h * 128 + sc); } }
        __syncthreads();
#pragma unroll
        for (int tl = 0; tl < 2; ++tl) {
#define ML_STEP(KS) { const s16x4 kl = att::tr_read<tl_off + (KS) * 4096>(vbK), kh = att::tr_read<tl_off + (KS) * 4096 + 2048>(vbK); \
            const s16x4 v0l = att::tr_read<tl_off + (KS) * 4096>(vbV), v0h = att::tr_read<tl_off + (KS) * 4096 + 2048>(vbV); \
            const s16x4 v1l = att::tr_read<tl_off + 512 + (KS) * 4096>(vbV), v1h = att::tr_read<tl_off + 512 + (KS) * 4096 + 2048>(vbV); \
            asm volatile("s_waitcnt lgkmcnt(0)" ::: "memory"); __builtin_amdgcn_sched_barrier(0); \
            const bf16x8 ka = ML_PK(kl, kh); \
            acc0 = __builtin_amdgcn_mfma_f32_32x32x16_bf16(ka, ML_PK(v0l, v0h), acc0, 0, 0, 0); \
            acc1 = __builtin_amdgcn_mfma_f32_32x32x16_bf16(ka, ML_PK(v1l, v1h), acc1, 0, 0, 0); \
            nacc = __builtin_amdgcn_mfma_f32_32x32x16_bf16(ka, ones, nacc, 0, 0, 0); }
            if (tl == 0) { constexpr int tl_off = 0; ML_STEP(0) ML_STEP(1) ML_STEP(2) ML_STEP(3) }
            else { constexpr int tl_off = 16384; ML_STEP(0) ML_STEP(1) ML_STEP(2) ML_STEP(3) }
#undef ML_STEP
        }
        __syncthreads();
    }
}

__device__ __forceinline__ void out_unit(const bf16_t* QKM, const bf16_t* VM, bf16_t* OM, const float* GT, const float* cw, const float* cb, const float* ng,
                                         const bf16_t* CT, const float* NP, const float* MP, int b, int h, int c, char* lds) {
    int tid_ = threadIdx.x; asm volatile("" : "+v"(tid_));
    const int tid = tid_, wid = tid >> 6, lane = tid & 63, r32 = lane & 31, hi = lane >> 5;
    float* XA = (float*)(lds + M3_X);
    const size_t row0 = (size_t)b * SEQ + 128 * c;
    if (wid < 2) { const int dir = wid; const size_t idx = (size_t)((b * 4 + h) * 2 + dir) * 16 + c; const float mprev = MP[idx];
        const float* gp = GT + (row0 + 2 * lane) * 16 + 8 * dir + h;
        const float li0 = gp[0], li1 = gp[16], lf0 = logsig(gp[4]), lf1 = logsig(gp[20]);
        const float incl = wscan_add(lf0 + lf1, lane), bl1 = incl, bl0 = incl - lf1, gtot = __shfl(incl, 63);
        float x0, x1, a0, a1, p0, p1;
        if (dir == 0) { x0 = bl0; x1 = bl1; a0 = li0 - x0; a1 = li1 - x1;
            const float ps = wscan_max(fmaxf(a0, a1), lane); float ex = __shfl_up(ps, 1); if (lane == 0) ex = -INFINITY; p0 = fmaxf(a0, ex); p1 = fmaxf(a1, p0); }
        else { x0 = gtot - bl0 + lf0; x1 = gtot - bl1 + lf1; a0 = li0 - x0; a1 = li1 - x1;
            const float ps = wrscan_max(fmaxf(a0, a1), lane); float ex = __shfl_down(ps, 1); if (lane == 63) ex = -INFINITY; p1 = fmaxf(a1, ex); p0 = fmaxf(a0, p1); }
        float* X = XA + dir * 128;
        X[2 * lane] = a0; X[2 * lane + 1] = a1; X[256 + 2 * lane] = fmaxf(mprev, p0); X[256 + 2 * lane + 1] = fmaxf(mprev, p1);
        X[512 + 2 * lane] = x0; X[512 + 2 * lane + 1] = x1;
        X[768 + 2 * lane] = NP[idx * 128 + 2 * lane]; X[768 + 2 * lane + 1] = NP[idx * 128 + 2 * lane + 1];
    }
    { const int sr = tid >> 4, sc = (tid & 15) * 8, kc = sc * 2;
      float w[3][8], bb[8]; ld_convw(cw, cb, 512 + h * 128 + sc, w, bb);
      const bf16_t* ctf = CT + ((size_t)((b * 4 + h) * 2 + 0) * 16 + c) * 16384; const bf16_t* ctb = CT + ((size_t)((b * 4 + h) * 2 + 1) * 16 + c) * 16384;
#pragma unroll
      for (int tl = 0; tl < 2; ++tl)
#pragma unroll
          for (int hf = 0; hf < 2; ++hf) { const int rl = 32 * hf + sr, sl = 64 * tl + rl, t = 128 * c + sl; const size_t row = (size_t)b * SEQ + t;
              float o[8]; conv_silu8(QKM + row * 1024 + 512 + h * 128 + sc, t, w, bb, o);
              *(bf16x8*)(lds + M3_K + tl * 16384 + KSWZ(rl, kc)) = pack8(o, DKS);
              *(bf16x8*)(lds + M3_V + tl * 16384 + att::v_st(rl, sc)) = *(const GAS bf16x8*)(VM + row * 512 + h * 128 + sc);
              *(bf16x8*)(lds + M3_CF + tl * 16384 + KSWZ(rl, kc)) = *(const GAS bf16x8*)(ctf + sl * 128 + sc);
              *(bf16x8*)(lds + M3_CB + tl * 16384 + KSWZ(rl, kc)) = *(const GAS bf16x8*)(ctb + sl * 128 + sc); } }
    const int dir = wid >> 2, tq = 32 * (wid & 3) + r32;
    bf16x8 qr[8];
    { const int t = 128 * c + tq; const bf16_t* qp = QKM + (row0 + tq) * 1024 + h * 128 + hi * 8;
#pragma unroll
      for (int d0 = 0; d0 < 8; ++d0) { float w[3][8], bb[8], o[8]; ld_convw(cw, cb, h * 128 + hi * 8 + 16 * d0, w, bb); conv_silu8(qp + 16 * d0, t, w, bb, o); qr[d0] = pack8(o, 1.f); } }
    __syncthreads();
    const float* X = XA + dir * 128;
    const float Mt = X[256 + tq], winter = __expf(MP[(size_t)((b * 4 + h) * 2 + dir) * 16 + c] - Mt), flo = __expf(-(X[512 + tq] + Mt));
    f32x16 o[4] = {}; float den = 0.f;
    const int vb0 = (int)(uintptr_t)lds + M3_V + att::v_rd_base(lane);
#pragma unroll
    for (int tl = 0; tl < 2; ++tl) {
        f32x16 p0, p1; att::qkt(p0, p1, (const att::bf16*)(lds + M3_K + tl * 16384), qr, r32, hi);
#pragma unroll
        for (int r = 0; r < 16; ++r) { const int s0 = 64 * tl + att::crow(r, hi), s1 = s0 + 32;
            const bool k0 = dir ? (s0 >= tq) : (s0 <= tq), k1 = dir ? (s1 >= tq) : (s1 <= tq);
            const float w0 = k0 ? __expf(fminf(X[s0] - Mt, 0.f)) : 0.f, w1 = k1 ? __expf(fminf(X[s1] - Mt, 0.f)) : 0.f;
            p0[r] *= w0; p1[r] *= w1; den += p0[r] + p1[r]; }
        bf16x8 pa0, pa1, pa2, pa3;
#define PK4(P, BASE, OUT) do { unsigned a0 = att::cvtpk(P[BASE + 0], P[BASE + 1]), a1 = att::cvtpk(P[BASE + 2], P[BASE + 3]);   \
    unsigned b0 = att::cvtpk(P[BASE + 4], P[BASE + 5]), b1 = att::cvtpk(P[BASE + 6], P[BASE + 7]);                              \
    auto r0 = __builtin_amdgcn_permlane32_swap(a0, b0, false, false); auto r1 = __builtin_amdgcn_permlane32_swap(a1, b1, false, false); \
    u32x4 w = {r0[0], r1[0], r0[1], r1[1]}; OUT = *reinterpret_cast<bf16x8*>(&w); } while (0)
        PK4(p0, 0, pa0); PK4(p0, 8, pa1); PK4(p1, 0, pa2); PK4(p1, 8, pa3);
#undef PK4
        att::pv_d0(o, vb0 + tl * 16384, pa0, pa1, pa2, pa3);
    }
    { auto rr = __builtin_amdgcn_permlane32_swap(__float_as_uint(den), __float_as_uint(den), false, false); den = __uint_as_float(rr[0]) + __uint_as_float(rr[1]); }
    { float dn = 0.f; const float* NPV = X + 768;
      const char* ctl = lds + (dir ? M3_CB : M3_CF);
#pragma unroll
      for (int kc = 0; kc < 8; ++kc) { const u32x4 qw = *reinterpret_cast<const u32x4*>(&qr[kc]); float qf[8] = {bflo(qw.x), bfhi(qw.x), bflo(qw.y), bfhi(qw.y), bflo(qw.z), bfhi(qw.z), bflo(qw.w), bfhi(qw.w)};
#pragma unroll
          for (int e = 0; e < 8; ++e) { dn += qf[e] * NPV[16 * kc + 8 * hi + e]; }
          const bf16x8 qs = pack8(qf, winter); const int cb2 = (16 * kc + 8 * hi) * 2;
#pragma unroll
          for (int d0 = 0; d0 < 4; ++d0) { const int rw = 32 * (d0 & 1) + r32;
              const bf16x8 cf = *(const bf16x8*)(ctl + (d0 >> 1) * 16384 + KSWZ(rw, cb2));
              o[d0] = __builtin_amdgcn_mfma_f32_32x32x16_bf16(qs, cf, o[d0], 0, 0, 0); } }
      { auto rr = __builtin_amdgcn_permlane32_swap(__float_as_uint(dn), __float_as_uint(dn), false, false); dn = __uint_as_float(rr[0]) + __uint_as_float(rr[1]); }
      den += winter * dn; }
    const float inv = 1.f / fmaxf(fabsf(den), flo);
    float* wsx = XA + 1024 + wid * 32;
    if (hi == 0) wsx[r32] = inv;
    asm volatile("s_waitcnt lgkmcnt(0)" ::: "memory");
    float rinv[16];
#pragma unroll
    for (int r = 0; r < 16; ++r) rinv[r] = wsx[att::crow(r, hi)];
    __syncthreads();
    float* H = (float*)lds;
    if (dir == 1) {
#pragma unroll
        for (int r = 0; r < 16; ++r) { const int t = 32 * (wid & 3) + att::crow(r, hi);
#pragma unroll
            for (int d0 = 0; d0 < 4; ++d0) H[t * 132 + 32 * d0 + r32] = o[d0][r] * rinv[r]; } }
    __syncthreads();
    if (dir == 0) {
#pragma unroll
        for (int r = 0; r < 16; ++r) { const int t = 32 * (wid & 3) + att::crow(r, hi);
#pragma unroll
            for (int d0 = 0; d0 < 4; ++d0) H[t * 132 + 32 * d0 + r32] += o[d0][r] * rinv[r]; } }
    __syncthreads();
    { const int t = tid >> 2, sg = tid & 3; const float* hp = H + t * 132 + 32 * sg; float v[32]; float s = 0.f;
#pragma unroll
      for (int e = 0; e < 32; ++e) { v[e] = hp[e]; s += v[e]; }
      s += __shfl_xor(s, 1); s += __shfl_xor(s, 2); const float mean = s * (1.f / 128.f); float q = 0.f;
#pragma unroll
      for (int e = 0; e < 32; ++e) { v[e] -= mean; q += v[e] * v[e]; }
      q += __shfl_xor(q, 1); q += __shfl_xor(q, 2); const float rstd = 1.f / sqrtf(q * (1.f / 128.f) + LN_EPS);
      bf16_t* op = OM + (row0 + t) * 512 + h * 128 + 32 * sg; const float* gp = ng + h * 128 + 32 * sg;
#pragma unroll
      for (int e8 = 0; e8 < 4; ++e8) { const v4u sw = *(const GAS v4u*)(op + 8 * e8);
          const float sg8[8] = {bflo(sw.x), bfhi(sw.x), bflo(sw.y), bfhi(sw.y), bflo(sw.z), bfhi(sw.z), bflo(sw.w), bfhi(sw.w)}; float ov[8];
#pragma unroll
          for (int e = 0; e < 8; ++e) ov[e] = v[8 * e8 + e] * rstd * gp[8 * e8 + e] * sg8[e];
          v4u r; r.x = pk2(ov[0], ov[1]); r.y = pk2(ov[2], ov[3]); r.z = pk2(ov[4], ov[5]); r.w = pk2(ov[6], ov[7]);
          *(GAS v4u*)(op + 8 * e8) = r; } }
    __syncthreads();
}
}
#define REPEAT_1(...) __VA_ARGS__
#define REPEAT_2(...) __VA_ARGS__ __VA_ARGS__
#define REPEAT_X(n, ...) REPEAT_##n(__VA_ARGS__)
#define REPEAT(n, ...) REPEAT_X(n, __VA_ARGS__)
#ifndef REP_P1
#define REP_P1 1
#endif
#ifndef REP_SCAN
#define REP_SCAN 1
#endif
#ifndef REP_P4
#define REP_P4 1
#endif
#ifndef REP_P5
#define REP_P5 1
#endif
#ifndef REP_P6
#define REP_P6 1
#endif
#ifndef REP_CONV
#define REP_CONV 1
#endif
#ifndef MIX_MLSTM
#define MIX_MLSTM 0
#endif
#ifndef MIX_GQA
#define MIX_GQA 0
#endif
__device__ __forceinline__ void gates_unit(const bf16_t* XN, const bf16_t* WgT, const float* bias, float* GT, int t, int wave, int lane) {
    const int fr = lane & 15, fq = lane >> 4;
    const f32x4 bv = *(const GAS f32x4*)(bias + 4 * fq);
    const GAS bf16x8* bp = (const GAS bf16x8*)(WgT + fr * 1024 + 8 * fq);
#pragma unroll
    for (int blk = 0; blk < 2; ++blk) {
        const int row = 256 * t + 32 * wave + 16 * blk + fr;
        const GAS bf16x8* ap = (const GAS bf16x8*)(XN + (size_t)row * 1024 + 8 * fq);
        f32x4 acc = {0.f, 0.f, 0.f, 0.f};
#pragma unroll 8
        for (int k = 0; k < 32; ++k) acc = __builtin_amdgcn_mfma_f32_16x16x32_bf16(bp[4 * k], ap[4 * k], acc, 0, 0, 0);
        *(GAS f32x4*)(GT + (size_t)row * 16 + 4 * fq) = acc + bv;
    }
}

__device__ __forceinline__ void qk_norm_rope(bf16_t* QA, bf16_t* KA, const float* gq, const float* gk, const float* rope, int idx, int cnt) {
    const int j = idx & 15; constexpr int NP = MG * 8 + MG * 2;
    for (int p = idx >> 4; p < NP; p += cnt >> 4) {
        int row; bf16_t* ptr; const float* gp;
        if (p < MG * 8) { row = p >> 3; ptr = QA + (size_t)row * 1024 + (p & 7) * 128 + 8 * j; gp = gq; }
        else { const int q = p - MG * 8; row = q >> 1; ptr = KA + (size_t)row * 256 + (q & 1) * 128 + 8 * j; gp = gk; }
        const v4u w = *(const GAS v4u*)ptr;
        float x[8] = {bflo(w.x), bfhi(w.x), bflo(w.y), bfhi(w.y), bflo(w.z), bfhi(w.z), bflo(w.w), bfhi(w.w)};
        float ss = 0.f;
#pragma unroll
        for (int e = 0; e < 8; ++e) ss += x[e] * x[e];
        ss += __shfl_xor(ss, 1); ss += __shfl_xor(ss, 2); ss += __shfl_xor(ss, 4); ss += __shfl_xor(ss, 8);
        const float rs = 1.f / sqrtf(ss * (1.f / 128.f) + LN_EPS);
        const int t = row & (SEQ - 1); const int pos = (j < 8) ? (t >> 6) : (t & 63);
        const bool second = (j & 4) != 0;
        const GAS f32x4* tb = (const GAS f32x4*)(rope + (size_t)(pos * 32 + 8 * (j & 3)) * 2);
        float o[8];
#pragma unroll
        for (int e2 = 0; e2 < 4; ++e2) { const f32x4 cssn = tb[e2];
#pragma unroll
            for (int k = 0; k < 2; ++k) { const int e = 2 * e2 + k; const float cs = cssn[2 * k], sn = cssn[2 * k + 1];
                const float xe = x[e] * rs * gp[8 * j + e];
                const float other = __shfl_xor(xe, 4);
                o[e] = second ? (xe * cs + other * sn) : (xe * cs - other * sn); } }
        v4u r; r.x = pk2(o[0], o[1]); r.y = pk2(o[2], o[3]); r.z = pk2(o[4], o[5]); r.w = pk2(o[6], o[7]);
        *(GAS v4u*)ptr = r;
    }
}

__device__ __forceinline__ void mixer_phases(const Args& a, unsigned char* lds_raw, int g, const XcdBarrier& grid, int tid, int bx, int G) {
    LAS unsigned char* lds = (LAS unsigned char*)lds_raw;
    const int lane = tid & 63, wave = __builtin_amdgcn_readfirstlane(tid >> 6);
    unsigned char* ws = a.ws;
    bf16_t* XN = (bf16_t*)(ws + WS_XN);
    {
        pg8::Gemm gm{XN, (const bf16_t*)(ws + WS_WIN), MG, NIN, DM}; pg8::StaticOrder S; S.init(MG, NIN, G, bx);
        pg8::EpiInProj E{(bf16_t*)(ws + WS_QKM), (bf16_t*)(ws + WS_VM), (bf16_t*)(ws + WS_OM), (bf16_t*)(ws + WS_QA), (bf16_t*)(ws + WS_KA), (bf16_t*)(ws + WS_VA), (bf16_t*)(ws + WS_QC), (bf16_t*)(ws + WS_GBR)};
        REPEAT(REP_P1, pg8::gemm_phase<pg8::EpiInProj, pg8::StaticOrder, true, true>(lds, gm, S, E);)
        for (int t = bx; t < MG / 256; t += G) gates_unit(XN, (const bf16_t*)(ws + WS_WG), a.in[7], (float*)(ws + WS_GT), t, wave, lane);
    }
    xcd_barrier(grid);
    {
        const int c = bx >= 192 ? bx - 192 : 1 << 20;
        pg8::Gemm gm{(const bf16_t*)(ws + WS_MEMB) + (size_t)g * MEMR * DM, (const bf16_t*)(ws + WS_WMEM), MEMR, 1024, DM}; pg8::StaticOrder S; S.init(MEMR, 1024, 64, c);
        pg8::EpiSplit E{(bf16_t*)(ws + WS_KC), 512, 512, (WS_VC - WS_KC) / 2};
        pg8::gemm_phase<pg8::EpiSplit, pg8::StaticOrder, true, true>(lds, gm, S, E);
#if MIX_MLSTM
        REPEAT(REP_SCAN, if (bx < 64) ml::scan_item((const bf16_t*)(ws + WS_QKM), (const bf16_t*)(ws + WS_VM), (const float*)(ws + WS_GT), a.in[8], a.in[9],
                                    (bf16_t*)(ws + WS_CT), (float*)(ws + WS_NP), (float*)(ws + WS_NP) + 1024 * 128, bx >> 3, (bx >> 1) & 3, bx & 1, (char*)lds_raw);)
#endif
#if MIX_GQA
        qk_norm_rope((bf16_t*)(ws + WS_QA), (bf16_t*)(ws + WS_KA), a.in[11], a.in[12], (const float*)(ws + WS_ROPE), bx * NTHR + tid, G * NTHR);
#endif
    }
    xcd_barrier(grid);
    {
#if MIX_GQA
        { const int vcu = (G % 8 == 0) ? (bx % 8) * (G / 8) + bx / 8 : bx;
          for (int u = vcu; u < BG * 8 * 8; u += G) {
            const int b = u >> 6, h = (u >> 3) & 7, qb = u & 7;
            att::bf16* Q = (att::bf16*)(ws + WS_QA) + (size_t)(b * SEQ + qb * 256) * 1024 + h * 128;
            const att::bf16* K = (const att::bf16*)(ws + WS_KA) + (size_t)(b * SEQ) * 256 + (h >> 2) * 128;
            const att::bf16* V = (const att::bf16*)(ws + WS_VA) + (size_t)(b * SEQ) * 256 + (h >> 2) * 128;
            att::attn_dense_body<1024, 256>(Q, K, V, Q, SEQ, (char*)lds_raw);
          } }
#endif
#if MIX_MLSTM
        for (int u = bx; u < BG * 4 * 16; u += G)
            ml::out_unit((const bf16_t*)(ws + WS_QKM), (const bf16_t*)(ws + WS_VM), (bf16_t*)(ws + WS_OM), (const float*)(ws + WS_GT), a.in[8], a.in[9], a.in[10],
                         (const bf16_t*)(ws + WS_CT), (const float*)(ws + WS_NP), (const float*)(ws + WS_NP) + 1024 * 128, u >> 6, (u >> 4) & 3, u & 15, (char*)lds_raw);
#endif
        for (int u = bx; u < BG * 4 * 8; u += G) {
            const int b = u >> 5, h = (u >> 3) & 3, qb = u & 7;
            att::bf16* Q = (att::bf16*)(ws + WS_QC) + (size_t)(b * SEQ + qb * 256) * 512 + h * 128;
            const att::bf16* K = (const att::bf16*)(ws + WS_KC) + (size_t)(b * NMEM) * 512 + h * 128;
            const att::bf16* V = (const att::bf16*)(ws + WS_VC) + (size_t)(b * NMEM) * 512 + h * 128;
            att::attn_dense_body<512, 512>(Q, K, V, Q, NMEM, (char*)lds_raw);
        }
    }
    xcd_barrier(grid);
    {
        pg8::StaticOrder S; S.init(MG, DM, G, bx);
        {
        float* SCR = (float*)(ws + WS_SCR); bf16_t* MERGED = (bf16_t*)(ws + WS_MERGED); const bf16_t* GBR = (const bf16_t*)(ws + WS_GBR);
#if MIX_MLSTM
        { pg8::Gemm gm{(const bf16_t*)(ws + WS_OM), (const bf16_t*)(ws + WS_WBM), MG, DM, 512}; pg8::EpiMerge<0> E{GBR, 0, SCR, MERGED};
          pg8::gemm_phase<pg8::EpiMerge<0>, pg8::StaticOrder, true, true>(lds, gm, S, E); }
#endif
#if MIX_GQA
        { pg8::Gemm gm{(const bf16_t*)(ws + WS_QA), (const bf16_t*)(ws + WS_WBA), MG, DM, 1024}; pg8::EpiMerge<MIX_MLSTM ? 1 : 0> E{GBR, 1024, SCR, MERGED};
          pg8::gemm_phase<pg8::EpiMerge<MIX_MLSTM ? 1 : 0>, pg8::StaticOrder, true, true>(lds, gm, S, E); }
#endif
        { constexpr int MODE = (MIX_MLSTM || MIX_GQA) ? 2 : 3;
          pg8::Gemm gm{(const bf16_t*)(ws + WS_QC), (const bf16_t*)(ws + WS_WBC), MG, DM, 512}; pg8::EpiMerge<MODE> E{GBR, 2048, SCR, MERGED};
          pg8::gemm_phase<pg8::EpiMerge<MODE>, pg8::StaticOrder, true, true>(lds, gm, S, E); }
        }
    }
    xcd_barrier(grid);
}

__device__ __forceinline__ int map_win(int n) { return n < 2048 ? n : n + 16; }
__device__ __forceinline__ int map_id(int n) { return n; }
__device__ __forceinline__ int map_up(int n) { return ((n >> 7) & 1) * DFF + (n >> 8) * 128 + (n & 127); }

__device__ __forceinline__ void p0_weights(const Args& a, LAS unsigned char* lds, int gw, int NGW, int wave, int lane, int gtid, int ngt) {
    LAS float* scr = (LAS float*)(lds + wave * 16384);
    unsigned char* ws = a.ws;
#define TRI(W, NSRC, K, NDST, WT, MAP) { constexpr int NI = ((K) / 64) * ((NDST) / 32); if (r < NI) { const int kb = r / ((NDST) / 32), nb = r % ((NDST) / 32); \
        transpose_item(W, NSRC, K, (bf16_t*)(ws + (WT)), 64 * kb, 32 * nb, MAP(32 * nb), scr, lane); continue; } r -= NI; }
    constexpr int NITEMS = 16 * 224 + 16 * 32 + 8 * 32 + 16 * 32 + 8 * 32 + 16 * 32 + 16 * 176 + 44 * 32;
    for (int it = gw; it < NITEMS; it += NGW) {
        int r = it;
        TRI(a.in[6], INW, 1024, NIN, WS_WIN, map_win)
        TRI(a.in[13], 1024, 1024, 1024, WS_WMEM, map_id)
        TRI(a.in[14], 1024, 512, 1024, WS_WBM, map_id)
        TRI(a.in[15], 1024, 1024, 1024, WS_WBA, map_id)
        TRI(a.in[16], 1024, 512, 1024, WS_WBC, map_id)
        TRI(a.in[17], 1024, 1024, 1024, WS_WOUT, map_id)
        TRI(a.in[20], NUP, 1024, NUP, WS_WUP, map_up)
        TRI(a.in[23], 1024, DFF, 1024, WS_WDN, map_id)
    }
#undef TRI
    if (gtid < 64 * 32) { const int pos = gtid >> 5, i = gtid & 31; const float ang = (float)pos * exp2f(-(float)i * (13.287712379549449f / 32.f));
        float sn, cs; sincosf(ang, &sn, &cs); float* tb = (float*)(ws + WS_ROPE); tb[2 * gtid] = cs; tb[2 * gtid + 1] = sn; }
    { bf16_t* wg = (bf16_t*)(ws + WS_WG); const GAS float* win = (const GAS float*)a.in[6];
      for (int i = gtid; i < 16 * 1024; i += ngt) { const int c = i >> 10, k = i & 1023; wg[i] = (bf16_t)(pk2(win[(size_t)k * INW + 2048 + c], 0.f) & 0xffffu); } }
    { bf16_t* mb = (bf16_t*)(ws + WS_MEMB); const int n8p = 8 * NMEM * DM / 8, n8 = 24 * NMEM * DM / 8;
      for (int i = gtid; i < n8; i += ngt) { const GAS f32x4* s = (i < n8p) ? (const GAS f32x4*)a.in[2] + 2 * (size_t)i : (const GAS f32x4*)a.in[3] + 2 * (size_t)(i - n8p);
          const f32x4 x0 = s[0], x1 = s[1]; v4u o; o.x = pk2(x0.x, x0.y); o.y = pk2(x0.z, x0.w); o.z = pk2(x1.x, x1.y); o.w = pk2(x1.z, x1.w); ((GAS v4u*)mb)[i] = o; } }
}

__device__ __forceinline__ void conv_pass(const bf16_t* U1, const bf16_t* U2, bf16_t* HID, const float* cw, const float* cb, int gtid, int ngt) {
    constexpr int CC = DFF / 8, RB = 16, TOTAL = (MG / RB) * CC;
    for (int it = gtid; it < TOTAL; it += ngt) {
        const int cc = it % CC, rb = it / CC, c = 8 * cc, r0 = rb * RB;
        float w1[3][8], w2[3][8], b1[8], b2[8];
#pragma unroll
        for (int j = 0; j < 3; ++j)
#pragma unroll
            for (int e = 0; e < 8; ++e) { w1[j][e] = cw[j * NUP + c + e]; w2[j][e] = cw[j * NUP + DFF + c + e]; }
#pragma unroll
        for (int e = 0; e < 8; ++e) { b1[e] = cb[c + e]; b2[e] = cb[DFF + c + e]; }
        const GAS v4u* p1 = (const GAS v4u*)(U1 + (size_t)r0 * DFF + c); const GAS v4u* p2 = (const GAS v4u*)(U2 + (size_t)r0 * DFF + c);
        constexpr int RS = DFF / 8;
        v4u a1, a2, c1, c2, n1, n2; const v4u z = {0u, 0u, 0u, 0u};
        if ((r0 % SEQ) == 0) { a1 = z; a2 = z; } else { a1 = p1[-RS]; a2 = p2[-RS]; }
        c1 = p1[0]; c2 = p2[0];
#pragma unroll 4
        for (int i = 0; i < RB; ++i) {
            const bool last = (i == RB - 1) && (((r0 + RB) % SEQ) == 0);
            if (last) { n1 = z; n2 = z; } else { n1 = p1[(size_t)(i + 1) * RS]; n2 = p2[(size_t)(i + 1) * RS]; }
            float o[8];
#pragma unroll
            for (int q = 0; q < 4; ++q) {
                const float y1l = w1[0][2 * q] * bflo(a1[q]) + w1[1][2 * q] * bflo(c1[q]) + w1[2][2 * q] * bflo(n1[q]) + b1[2 * q];
                const float y1h = w1[0][2 * q + 1] * bfhi(a1[q]) + w1[1][2 * q + 1] * bfhi(c1[q]) + w1[2][2 * q + 1] * bfhi(n1[q]) + b1[2 * q + 1];
                const float y2l = w2[0][2 * q] * bflo(a2[q]) + w2[1][2 * q] * bflo(c2[q]) + w2[2][2 * q] * bflo(n2[q]) + b2[2 * q];
                const float y2h = w2[0][2 * q + 1] * bfhi(a2[q]) + w2[1][2 * q + 1] * bfhi(c2[q]) + w2[2][2 * q + 1] * bfhi(n2[q]) + b2[2 * q + 1];
                o[2 * q] = gelu_tanh(y1l) * y2l; o[2 * q + 1] = gelu_tanh(y1h) * y2h; }
            v4u w; w.x = pk2(o[0], o[1]); w.y = pk2(o[2], o[3]); w.z = pk2(o[4], o[5]); w.w = pk2(o[6], o[7]);
            *(GAS v4u*)(HID + (size_t)(r0 + i) * DFF + c) = w;
            a1 = c1; a2 = c2; c1 = n1; c2 = n2;
        }
    }
}
#ifndef ENABLE_MIX
#define ENABLE_MIX 0
#endif
__global__ void __launch_bounds__(NTHR, 2) mega_fwd(Args a) {
    extern __shared__ __attribute__((aligned(16))) unsigned char lds_raw[];
    LAS unsigned char* lds = (LAS unsigned char*)lds_raw;
    cg::grid_group grid = cg::this_grid();
    const int G = gridDim.x, NGW = G * NWAVES, ngt = G * NTHR;
    {
        const int tid = threadIdx.x, lane = tid & 63, wave = __builtin_amdgcn_readfirstlane(tid >> 6), bx = blockIdx.x;
        p0_weights(a, lds, bx * NWAVES + wave, NGW, wave, lane, bx * NTHR + tid, ngt);
    }
    unsigned* barw = (unsigned*)(a.ws + WS_CTL);
    if (blockIdx.x == 0) { for (int i = threadIdx.x; i < XCD_BAR_WORDS; i += NTHR) __hip_atomic_store(barw + i, 0u, __ATOMIC_RELAXED, __HIP_MEMORY_SCOPE_AGENT); }
    if (threadIdx.x < 2) ((volatile LAS unsigned*)(lds + BAR_LDS_OFF))[threadIdx.x] = 0u;
    XcdBarrier bar; bar.bar = barw; bar.x = xb_xcc_id(); bar.st = (volatile LAS unsigned*)(lds + BAR_LDS_OFF);
    for (int g = 0; g < NGRP; ++g) {
        int tid_ = threadIdx.x, bx_ = blockIdx.x; asm volatile("" : "+v"(tid_), "+s"(bx_));
        const int tid = tid_, bx = bx_, lane = tid & 63, wave = __builtin_amdgcn_readfirstlane(tid >> 6);
        const int gw = bx * NWAVES + wave, gtid = bx * NTHR + tid;
        unsigned char* ws = a.ws;
        bf16_t* XN = (bf16_t*)(ws + WS_XN); float* STATS = (float*)(ws + WS_STATS);
        const float* xg = (g == 0) ? a.in[0] : a.in[1] + (size_t)(g - 1) * MG * DM;
        float* outg = a.out + (size_t)g * MG * DM;
        for (int m = gw; m < MG; m += NGW) ln_row(xg + (size_t)m * DM, a.in[4], a.in[5], nullptr, XN + (size_t)m * DM, STATS + 2 * m, lane);
        if (g == 0) { __syncthreads(); grid.sync(); if (threadIdx.x == 0) (void)xb_add(&barw[XB_XCNT(bar.x)], 1u); }
        else xcd_barrier(bar);
#if ENABLE_MIX
        mixer_phases(a, lds_raw, g, bar, tid, bx, G);
#endif
        {
#if ENABLE_MIX
            pg8::Gemm gm{(const bf16_t*)(ws + WS_MERGED), (const bf16_t*)(ws + WS_WOUT), MG, DM, DM}; pg8::StaticOrder S; S.init(MG, DM, G, bx);
            pg8::EpiWout E{xg, STATS, a.in[4], a.in[5], outg, ALPHA};
            REPEAT(REP_P5, pg8::gemm_phase<pg8::EpiWout, pg8::StaticOrder, true, true>(lds, gm, S, E);)
#else
            for (int i = gtid; i < MG * DM / 4; i += ngt) { const int row = i >> 8, c4 = i & 255; const f32x4 xv = ((const GAS f32x4*)xg)[i];
                const f32x4 gv = ((const GAS f32x4*)a.in[4])[c4], bv = ((const GAS f32x4*)a.in[5])[c4];
                ((GAS f32x4*)outg)[i] = ((xv - STATS[2 * row]) * STATS[2 * row + 1] * gv + bv) * ALPHA; }
#endif
        }
        xcd_barrier(bar);
        for (int m = gw; m < MG; m += NGW) ln_row(outg + (size_t)m * DM, a.in[18], a.in[19], outg + (size_t)m * DM, XN + (size_t)m * DM, nullptr, lane);
        xcd_barrier(bar);
        {
            pg8::Gemm gm{XN, (const bf16_t*)(ws + WS_WUP), MG, NUP, DM}; pg8::StaticOrder S; S.init(MG, NUP, G, bx);
            pg8::EpiUp E{(bf16_t*)(ws + WS_U1), (bf16_t*)(ws + WS_U2), DFF};
            REPEAT(REP_P6, pg8::gemm_phase<pg8::EpiUp, pg8::StaticOrder, true, true>(lds, gm, S, E);)
        }
        xcd_barrier(bar);
        REPEAT(REP_CONV, conv_pass((const bf16_t*)(ws + WS_U1), (const bf16_t*)(ws + WS_U2), (bf16_t*)(ws + WS_HID), a.in[21], a.in[22], gtid, ngt);)
        xcd_barrier(bar);
        {
            pg8::Gemm gm{(const bf16_t*)(ws + WS_HID), (const bf16_t*)(ws + WS_WDN), MG, DM, DFF}; pg8::StaticOrder S; S.init(MG, DM, G, bx);
            pg8::EpiResF32 E{outg, DM, ALPHA};
            pg8::gemm_phase<pg8::EpiResF32, pg8::StaticOrder, true, true>(lds, gm, S, E);
        }
        xcd_barrier(bar);
        for (int m = gw; m < MG; m += NGW) ln_row(outg + (size_t)m * DM, a.in[24], a.in[25], outg + (size_t)m * DM, nullptr, nullptr, lane);
    }
}

extern "C" void kernel_launch(void* const* d_in, const int* in_sizes, int n_in, void* d_out, int out_size, void* d_ws, size_t ws_size, hipStream_t stream) {
    static int grid = 0;
    if (grid == 0) {
        if (n_in != 26 || ws_size < WS_END || out_size != 3 * MG * DM) { fprintf(stderr, "kernel_launch: unexpected shapes: n_in %d out %d ws %zu (need %zu)\n", n_in, out_size, ws_size, (size_t)WS_END); grid = -1; return; }
        int dev = 0, cus = 0, per_cu = 0;
        if (hipGetDevice(&dev) != hipSuccess || hipDeviceGetAttribute(&cus, hipDeviceAttributeMultiprocessorCount, dev) != hipSuccess) { grid = -1; return; }
        if (hipFuncSetAttribute((const void*)mega_fwd, hipFuncAttributeMaxDynamicSharedMemorySize, LDS_BYTES) != hipSuccess) { fprintf(stderr, "kernel_launch: hipFuncSetAttribute failed\n"); grid = -1; return; }
        if (hipOccupancyMaxActiveBlocksPerMultiprocessor(&per_cu, (const void*)mega_fwd, NTHR, LDS_BYTES) != hipSuccess || per_cu < 1) { fprintf(stderr, "kernel_launch: occupancy query failed (%d)\n", per_cu); per_cu = 1; }
        (void)hipGetLastError();
        grid = cus;
    }
    if (grid < 0) return;
    Args a{};
    for (int i = 0; i < 26; ++i) a.in[i] = (const float*)d_in[i];
    a.out = (float*)d_out; a.ws = (unsigned char*)d_ws;
    void* args[] = {&a};
    hipError_t e = hipLaunchCooperativeKernel((const void*)mega_fwd, dim3(grid), dim3(NTHR), args, LDS_BYTES, stream);
    if (e != hipSuccess) fprintf(stderr, "kernel_launch: cooperative launch failed: %s (grid %d)\n", hipGetErrorString(e), grid);
}
```

```cpp
#include <hip/hip_runtime.h>
#include <hip/hip_cooperative_groups.h>
#include <cstdio>
#include <cstdint>
namespace cg = cooperative_groups;
#define ENABLE_MIX 1
#define MIX_MLSTM 1
#define MIX_GQA 1
namespace pg8 {
#define PG8_LAS __attribute__((address_space(3)))
typedef unsigned short bf16_t;
typedef short bf16x8 __attribute__((ext_vector_type(8)));
typedef float f32x4 __attribute__((ext_vector_type(4)));
typedef unsigned u32x4 __attribute__((ext_vector_type(4)));
constexpr int BM = 256, BK = 64, HALF = 128, HTB = HALF * BK * 2  , STAGE_BYTES = 8 * HTB, NXCD = 8, WGM = 8;

__host__ __device__ __forceinline__ int lds_byte(int r, int c) { const int st = (r >> 4) * 2 + (c >> 5), rr = r & 15, cc = c & 31, ob = rr * 64 + cc * 2; return st * 1024 + (ob ^ (((ob >> 9) & 1) << 5)); }
__host__ __device__ __forceinline__ void stage_rc(int b, int& R, int& C) { const int st = b / 1024, sb = b % 1024, swz = sb ^ (((sb >> 9) & 1) << 5); R = (st >> 1) * 16 + swz / 64; C = (st & 1) * 32 + (swz % 64) / 2; }
__host__ __device__ __forceinline__ int perm32(int rho) { const int n = rho >> 4, i = rho & 15; return 8 * (i >> 2) + 4 * n + (i & 3); }

struct Unit { int pm, pn; };
struct Gemm { const bf16_t* A; const bf16_t* Bt; int M, N, K; };

struct StaticOrder {
    int nM, nN, nwg, G, c;
    __host__ __device__ void init(int M, int N, int G_, int c_) { nM = M / BM; nN = N / BM; nwg = nM * nN; G = G_; c = c_; }
    __host__ __device__ bool next(int i, Unit& u) const {
        const long L = (long)i * G + c; if (L >= nwg) return false;
        int wgid = (int)L; { const int q = nwg / NXCD, r = nwg % NXCD, xcd = wgid % NXCD, off = wgid / NXCD; wgid = (xcd < r ? xcd * (q + 1) : r * (q + 1) + (xcd - r) * q) + off; }
        const int nig = WGM * nN, gid = wgid / nig, fm = gid * WGM, gsz = (nM - fm) < WGM ? (nM - fm) : WGM;
        u.pm = fm + ((wgid % nig) % gsz); u.pn = (wgid % nig) / gsz; return true;
    }
    __device__ __forceinline__ void a_ready(const Unit&) const {}
    __device__ __forceinline__ void done(const Unit&) const {}
};

__device__ __forceinline__ unsigned cvt_pk_bf16(float lo, float hi) { unsigned r; asm volatile("v_cvt_pk_bf16_f32 %0, %1, %2" : "=v"(r) : "v"(lo), "v"(hi)); return r; }
typedef float f32x2 __attribute__((ext_vector_type(2)));
__device__ __forceinline__ f32x2 gelu_pk(f32x2 v) {
    const f32x2 av = __builtin_elementwise_abs(v), d = av * 0.2316418882f + 1.0f;
    f32x2 t; t.x = __builtin_amdgcn_rcpf(d.x); t.y = __builtin_amdgcn_rcpf(d.y);
    f32x2 q = t * 0.5307027145f + (-0.7265760135f); q = q * t + 0.7107068705f; q = q * t + (-0.142248368f); q = q * t + 0.127414796f; q = q * t;
    const f32x2 s = (v * v) * (-0.72134752044f);
    f32x2 e; e.x = __builtin_amdgcn_exp2f(s.x); e.y = __builtin_amdgcn_exp2f(s.y);
    const f32x2 m = v * (q * e), r = v - m;
    f32x2 o; o.x = v.x < 0.f ? m.x : r.x; o.y = v.y < 0.f ? m.y : r.y; return o;
}

#define PG8_GAS __attribute__((address_space(1)))
__device__ __forceinline__ float sigm(float x) { return __builtin_amdgcn_rcpf(1.0f + __expf(-x)); }
__device__ __forceinline__ void st8_bf16(bf16_t* p, const f32x4 v0, const f32x4 v1) {
    u32x4 w; w.x = cvt_pk_bf16(v0[0], v0[1]); w.y = cvt_pk_bf16(v0[2], v0[3]); w.z = cvt_pk_bf16(v1[0], v1[1]); w.w = cvt_pk_bf16(v1[2], v1[3]);
    *(PG8_GAS u32x4*)p = w;
}
__device__ __forceinline__ void ld8_bf16(const bf16_t* p, f32x4& v0, f32x4& v1) {
    const u32x4 w = *(const PG8_GAS u32x4*)p;
    v0[0] = __uint_as_float(w.x << 16); v0[1] = __uint_as_float(w.x & 0xffff0000u); v0[2] = __uint_as_float(w.y << 16); v0[3] = __uint_as_float(w.y & 0xffff0000u);
    v1[0] = __uint_as_float(w.z << 16); v1[1] = __uint_as_float(w.z & 0xffff0000u); v1[2] = __uint_as_float(w.w << 16); v1[3] = __uint_as_float(w.w & 0xffff0000u);
}
struct EpiInProj {
    static constexpr bool PERM = true, AFTER_DRAIN = false;
    bf16_t *QKM, *VM, *OM, *QA, *KA, *VA, *QC, *GBR;
    __device__ __forceinline__ void operator()(const f32x4 (&acc)[2][2][4][2], const Unit& u, int wr, int wc, int fr, int fq) const {
        const int pn = u.pn; bf16_t* base; int ld, cb; bool act = false;
        if (pn < 4) { base = QKM; ld = 1024; cb = 256 * pn; }
        else if (pn < 6) { base = VM; ld = 512; cb = 256 * (pn - 4); }
        else if (pn < 8) { base = OM; ld = 512; cb = 256 * (pn - 6); act = true; }
        else if (pn < 12) { base = QA; ld = 1024; cb = 256 * (pn - 8); }
        else if (pn == 12) { base = KA; ld = 256; cb = 0; }
        else if (pn == 13) { base = VA; ld = 256; cb = 0; }
        else if (pn < 16) { base = QC; ld = 512; cb = 256 * (pn - 14); }
        else { base = GBR; ld = 3072; cb = 256 * (pn - 16); act = true; }
        const int row0 = u.pm * BM + wr * 64 + fr, col0 = cb + wc * 32 + 8 * fq;
#pragma unroll
        for (int ai = 0; ai < 2; ++ai)
#pragma unroll
            for (int m = 0; m < 4; ++m) { bf16_t* rowp = base + (size_t)(row0 + ai * HALF + m * 16) * ld + col0;
#pragma unroll
                for (int bj = 0; bj < 2; ++bj) { f32x4 v0 = acc[ai][bj][m][0], v1 = acc[ai][bj][m][1];
                    if (act) {
#pragma unroll
                        for (int e = 0; e < 4; ++e) { v0[e] = sigm(v0[e]); v1[e] = sigm(v1[e]); } }
                    st8_bf16(rowp + bj * HALF, v0, v1); } }
    }
};
struct EpiSplit {
    static constexpr bool PERM = true, AFTER_DRAIN = false;
    bf16_t* O; int ld, split; size_t stride;
    __device__ __forceinline__ void operator()(const f32x4 (&acc)[2][2][4][2], const Unit& u, int wr, int wc, int fr, int fq) const {
        int colt = u.pn * BM; const int t = colt / split; colt -= t * split; bf16_t* base = O + (size_t)t * stride;
        const int row0 = u.pm * BM + wr * 64 + fr, col0 = colt + wc * 32 + 8 * fq;
#pragma unroll
        for (int ai = 0; ai < 2; ++ai)
#pragma unroll
            for (int m = 0; m < 4; ++m) { bf16_t* rowp = base + (size_t)(row0 + ai * HALF + m * 16) * ld + col0;
#pragma unroll
                for (int bj = 0; bj < 2; ++bj) st8_bf16(rowp + bj * HALF, acc[ai][bj][m][0], acc[ai][bj][m][1]); }
    }
};
struct EpiUp {
    static constexpr bool PERM = true, AFTER_DRAIN = false;
    bf16_t *U1, *U2; int ld;
    __device__ __forceinline__ void operator()(const f32x4 (&acc)[2][2][4][2], const Unit& u, int wr, int wc, int fr, int fq) const {
        const int row0 = u.pm * BM + wr * 64 + fr, col0 = u.pn * HALF + wc * 32 + 8 * fq;
#pragma unroll
        for (int ai = 0; ai < 2; ++ai)
#pragma unroll
            for (int m = 0; m < 4; ++m) { const size_t off = (size_t)(row0 + ai * HALF + m * 16) * ld + col0;
                st8_bf16(U1 + off, acc[ai][0][m][0], acc[ai][0][m][1]); st8_bf16(U2 + off, acc[ai][1][m][0], acc[ai][1][m][1]); }
    }
};
struct EpiResF32 {
    static constexpr bool PERM = true, AFTER_DRAIN = false;
    float* out; int ld; float alpha;
    __device__ __forceinline__ void operator()(const f32x4 (&acc)[2][2][4][2], const Unit& u, int wr, int wc, int fr, int fq) const {
        const int row0 = u.pm * BM + wr * 64 + fr, col0 = u.pn * BM + wc * 32 + 8 * fq;
#pragma unroll
        for (int ai = 0; ai < 2; ++ai)
#pragma unroll
            for (int m = 0; m < 4; ++m) { float* rowp = out + (size_t)(row0 + ai * HALF + m * 16) * ld + col0;
#pragma unroll
                for (int bj = 0; bj < 2; ++bj) { PG8_GAS f32x4* p = (PG8_GAS f32x4*)(rowp + bj * HALF);
                    const f32x4 a0 = p[0], a1 = p[1]; p[0] = a0 * alpha + acc[ai][bj][m][0]; p[1] = a1 * alpha + acc[ai][bj][m][1]; } }
    }
};
struct EpiWout {
    static constexpr bool PERM = true, AFTER_DRAIN = false;
    const float* x; const float* stats; const float* g; const float* b; float* out; float alpha;
    __device__ __forceinline__ void operator()(const f32x4 (&acc)[2][2][4][2], const Unit& u, int wr, int wc, int fr, int fq) const {
        const int row0 = u.pm * BM + wr * 64 + fr, col0 = u.pn * BM + wc * 32 + 8 * fq;
        f32x4 gv[2][2], bv[2][2];
#pragma unroll
        for (int bj = 0; bj < 2; ++bj)
#pragma unroll
            for (int n = 0; n < 2; ++n) { gv[bj][n] = *(const PG8_GAS f32x4*)(g + col0 + bj * HALF + 4 * n); bv[bj][n] = *(const PG8_GAS f32x4*)(b + col0 + bj * HALF + 4 * n); }
#pragma unroll
        for (int ai = 0; ai < 2; ++ai)
#pragma unroll
            for (int m = 0; m < 4; ++m) { const int row = row0 + ai * HALF + m * 16; const size_t off = (size_t)row * 1024 + col0;
                const float mu = stats[2 * row], rs = stats[2 * row + 1];
#pragma unroll
                for (int bj = 0; bj < 2; ++bj)
#pragma unroll
                    for (int n = 0; n < 2; ++n) { const f32x4 xv = *(const PG8_GAS f32x4*)(x + off + bj * HALF + 4 * n);
                        const f32x4 xn = (xv - mu) * rs * gv[bj][n] + bv[bj][n];
                        *(PG8_GAS f32x4*)(out + off + bj * HALF + 4 * n) = xn * alpha + acc[ai][bj][m][n]; } }
    }
};
template <int MODE> struct EpiMerge {
    static constexpr bool PERM = true, AFTER_DRAIN = false;
    const bf16_t* GBR; int goff; float* S; bf16_t* MERGED;
    __device__ __forceinline__ void operator()(const f32x4 (&acc)[2][2][4][2], const Unit& u, int wr, int wc, int fr, int fq) const {
        const int row0 = u.pm * BM + wr * 64 + fr, col0 = u.pn * BM + wc * 32 + 8 * fq;
#pragma unroll
        for (int ai = 0; ai < 2; ++ai)
#pragma unroll
            for (int m = 0; m < 4; ++m) { const int row = row0 + ai * HALF + m * 16;
#pragma unroll
                for (int bj = 0; bj < 2; ++bj) { const int c = col0 + bj * HALF; f32x4 g0, g1; ld8_bf16(GBR + (size_t)row * 3072 + goff + c, g0, g1);
                    f32x4 v0 = g0 * acc[ai][bj][m][0], v1 = g1 * acc[ai][bj][m][1];
                    PG8_GAS f32x4* sp = (PG8_GAS f32x4*)(S + (size_t)row * 1024 + c);
                    if (MODE == 1 || MODE == 2) { v0 += sp[0]; v1 += sp[1]; }
                    if (MODE <= 1) { sp[0] = v0; sp[1] = v1; } else st8_bf16(MERGED + (size_t)row * 1024 + c, v0, v1); } }
    }
};
template <class Epi, class Sched, bool ALIGN_EPI = false, bool SP2 = false>
__device__ __forceinline__ void gemm_phase(PG8_LAS unsigned char* lds, const Gemm g, const Sched& S, const Epi& E) {
    int tid_ = threadIdx.x; asm volatile("" : "+v"(tid_));
    const int tid = tid_, wid = __builtin_amdgcn_readfirstlane(tid >> 6), lane = tid & 63, wr = wid >> 2, wc = wid & 3, fr = lane & 15, fq = lane >> 4;
    const int K = g.K, nt = K / BK;
    unsigned voffA[2], voffB[2];
#pragma unroll
    for (int i = 0; i < 2; ++i) { int R, C; stage_rc(tid * 16 + i * 8192, R, C); const int Rb = Epi::PERM ? ((R & ~31) + perm32(R & 31)) : R;
        voffA[i] = (unsigned)(R * K + C) * 2u; voffB[i] = (unsigned)(Rb * K + C) * 2u; }
    const size_t kstep = (size_t)(BK * 2);
    const size_t hstep = (size_t)HALF * K * 2;
    const size_t tstep = 2 * hstep;
    const unsigned ldsw = (unsigned)wid * 1024u;
    const int aoff = lds_byte(wr * 64 + fr, fq * 8), boff = lds_byte(wc * 32 + fr, fq * 8);
#define PG8_SA(b, h) (((b) * 2 + (h)) * HTB)
#define PG8_SB(b, h) ((4 + (b) * 2 + (h)) * HTB)
#define PG8_STAGE(bufoff, gbase, voff) do { _Pragma("unroll") for (int _i = 0; _i < 2; ++_i) \
        __builtin_amdgcn_global_load_lds((const unsigned*)((const char*)(gbase) + (voff)[_i]), (PG8_LAS unsigned*)(lds + (bufoff) + ldsw + _i * 8192), 16, 0, 0); } while (0)
#define PG8_LDA(dst, b, h) do { _Pragma("unroll") for (int m = 0; m < 4; ++m) _Pragma("unroll") for (int k = 0; k < 2; ++k) dst[m][k] = *(const PG8_LAS bf16x8*)(lds + PG8_SA(b, h) + aoff + m * 2048 + k * 1024); } while (0)
#define PG8_LDB(dst, b, h) do { _Pragma("unroll") for (int n = 0; n < 2; ++n) _Pragma("unroll") for (int k = 0; k < 2; ++k) dst[n][k] = *(const PG8_LAS bf16x8*)(lds + PG8_SB(b, h) + boff + n * 2048 + k * 1024); } while (0)
#define PG8_MMA(ai, bj, At, Bt) do { __builtin_amdgcn_s_setprio(1); _Pragma("unroll") for (int m = 0; m < 4; ++m) _Pragma("unroll") for (int n = 0; n < 2; ++n) _Pragma("unroll") for (int k = 0; k < 2; ++k) \
        acc[ai][bj][m][n] = __builtin_amdgcn_mfma_f32_16x16x32_bf16(Bt[n][k], At[m][k], acc[ai][bj][m][n], 0, 0, 0); __builtin_amdgcn_s_setprio(0); } while (0)
#define PG8_WAIT_V(n) asm volatile("s_waitcnt vmcnt(" #n ")" ::: "memory")
#define PG8_WAIT_L(n) asm volatile("s_waitcnt lgkmcnt(" #n ")" ::: "memory")
#define PG8_BAR __builtin_amdgcn_s_barrier()
#define PG8_SCHED __builtin_amdgcn_sched_barrier(0)
    Unit cur, nxt; int ui = 0;
    if (!S.next(0, cur)) return;
    f32x4 acc[2][2][4][2];
#pragma unroll
    for (int a = 0; a < 2; ++a)
#pragma unroll
        for (int b = 0; b < 2; ++b)
#pragma unroll
            for (int m = 0; m < 4; ++m)
#pragma unroll
                for (int n = 0; n < 2; ++n) acc[a][b][m][n] = (f32x4){0.f, 0.f, 0.f, 0.f};
    bf16x8 At[4][2], B0[2][2], B1[2][2];
    const char* cA = (const char*)g.A + (size_t)cur.pm * tstep; const char* cB = (const char*)g.Bt + (size_t)cur.pn * tstep;
    S.a_ready(cur);
    if constexpr (SP2) {
        PG8_STAGE(PG8_SB(0, 0), cB, voffB); PG8_STAGE(PG8_SB(0, 1), cB + hstep, voffB); PG8_STAGE(PG8_SA(0, 0), cA, voffA); PG8_STAGE(PG8_SA(0, 1), cA + hstep, voffA);
        if (wr == 1) PG8_BAR;
        PG8_WAIT_V(2); PG8_BAR;
        PG8_STAGE(PG8_SB(1, 0), cB + kstep, voffB); PG8_STAGE(PG8_SA(1, 0), cA + kstep, voffA); PG8_STAGE(PG8_SB(1, 1), cB + hstep + kstep, voffB);
        PG8_WAIT_V(6); PG8_BAR;
    } else {
        PG8_STAGE(PG8_SB(0, 0), cB, voffB); PG8_STAGE(PG8_SA(0, 0), cA, voffA); PG8_STAGE(PG8_SB(0, 1), cB + hstep, voffB); PG8_STAGE(PG8_SA(0, 1), cA + hstep, voffA);
        if (wr == 1) PG8_BAR;
        PG8_WAIT_V(4); PG8_BAR;
        PG8_STAGE(PG8_SB(1, 0), cB + kstep, voffB); PG8_STAGE(PG8_SA(1, 0), cA + kstep, voffA); PG8_STAGE(PG8_SB(1, 1), cB + hstep + kstep, voffB);
        PG8_WAIT_V(6); PG8_BAR;
    }
    for (;;) {
        const bool has_next = S.next(ui + 1, nxt);
        const char* nA = has_next ? (const char*)g.A + (size_t)nxt.pm * tstep : cA; const char* nB = has_next ? (const char*)g.Bt + (size_t)nxt.pn * tstep : cB;
        for (int t = 0; t < nt; t += 2) {
            const bool last = (t == nt - 2);
            const char* a1 = cA + (size_t)(t + 1) * kstep;
            const char* a2 = last ? nA : cA + (size_t)(t + 2) * kstep; const char* b2 = last ? nB : cB + (size_t)(t + 2) * kstep;
            const char* a3 = a2 + kstep; const char* b3 = b2 + kstep;
            if (last && has_next) S.a_ready(nxt);
            if constexpr (SP2) {
            PG8_LDB(B0, 0, 0); PG8_LDB(B1, 0, 1); PG8_SCHED; PG8_LDA(At, 0, 0); PG8_STAGE(PG8_SA(1, 1), a1 + hstep, voffA);
            PG8_WAIT_V(8); PG8_WAIT_L(0); PG8_BAR; PG8_MMA(0, 0, At, B0); PG8_MMA(0, 1, At, B1); PG8_BAR; PG8_SCHED;
            PG8_LDA(At, 0, 1); PG8_STAGE(PG8_SB(0, 0), b2, voffB); PG8_STAGE(PG8_SB(0, 1), b2 + hstep, voffB); PG8_STAGE(PG8_SA(0, 0), a2, voffA);
            PG8_WAIT_V(8); PG8_WAIT_L(0); PG8_BAR; PG8_MMA(1, 0, At, B0); PG8_MMA(1, 1, At, B1); PG8_BAR; PG8_SCHED;
            PG8_LDB(B0, 1, 0); PG8_LDB(B1, 1, 1); PG8_SCHED; PG8_LDA(At, 1, 0); PG8_STAGE(PG8_SA(0, 1), a2 + hstep, voffA);
            PG8_WAIT_V(8); PG8_WAIT_L(0); PG8_BAR; PG8_MMA(0, 0, At, B0); PG8_MMA(0, 1, At, B1); PG8_BAR; PG8_SCHED;
            PG8_LDA(At, 1, 1); PG8_STAGE(PG8_SB(1, 0), b3, voffB); PG8_STAGE(PG8_SB(1, 1), b3 + hstep, voffB); PG8_STAGE(PG8_SA(1, 0), a3, voffA);
            PG8_WAIT_V(8); PG8_WAIT_L(0); PG8_BAR; PG8_MMA(1, 0, At, B0); PG8_MMA(1, 1, At, B1); PG8_BAR; PG8_SCHED;
            } else {
            PG8_LDB(B0, 0, 0); PG8_SCHED; PG8_LDA(At, 0, 0); PG8_STAGE(PG8_SA(1, 1), a1 + hstep, voffA);
            PG8_WAIT_L(8); PG8_BAR; PG8_WAIT_L(0); PG8_MMA(0, 0, At, B0); PG8_BAR; PG8_SCHED;
            PG8_LDB(B1, 0, 1); PG8_STAGE(PG8_SB(0, 0), b2, voffB);
            PG8_BAR; PG8_WAIT_L(0); PG8_MMA(0, 1, At, B1); PG8_BAR;
            PG8_LDA(At, 0, 1); PG8_STAGE(PG8_SA(0, 0), a2, voffA);
            PG8_BAR; PG8_WAIT_L(0); PG8_MMA(1, 0, At, B0); PG8_BAR; PG8_SCHED;
            PG8_STAGE(PG8_SB(0, 1), b2 + hstep, voffB);
            PG8_WAIT_V(6); PG8_BAR; PG8_MMA(1, 1, At, B1); PG8_BAR;
            PG8_LDB(B0, 1, 0); PG8_SCHED; PG8_LDA(At, 1, 0); PG8_STAGE(PG8_SA(0, 1), a2 + hstep, voffA);
            PG8_WAIT_L(8); PG8_BAR; PG8_WAIT_L(0); PG8_MMA(0, 0, At, B0); PG8_BAR; PG8_SCHED;
            PG8_LDB(B1, 1, 1); PG8_STAGE(PG8_SB(1, 0), b3, voffB);
            PG8_BAR; PG8_WAIT_L(0); PG8_MMA(0, 1, At, B1); PG8_BAR;
            PG8_LDA(At, 1, 1); PG8_STAGE(PG8_SA(1, 0), a3, voffA);
            PG8_BAR; PG8_WAIT_L(0); PG8_MMA(1, 0, At, B0); PG8_BAR; PG8_SCHED;
            PG8_STAGE(PG8_SB(1, 1), b3 + hstep, voffB);
            PG8_WAIT_V(6); PG8_BAR; PG8_MMA(1, 1, At, B1); PG8_BAR;
            }
        }
        if constexpr (ALIGN_EPI) { if (wr == 0) PG8_BAR; }
        if constexpr (!Epi::AFTER_DRAIN) { E(acc, cur, wr, wc, fr, fq); S.done(cur); }
        if (!has_next) break;
#pragma unroll
        for (int a = 0; a < 2; ++a)
#pragma unroll
            for (int b = 0; b < 2; ++b)
#pragma unroll
                for (int m = 0; m < 4; ++m)
#pragma unroll
                    for (int n = 0; n < 2; ++n) acc[a][b][m][n] = (f32x4){0.f, 0.f, 0.f, 0.f};
        cur = nxt; cA = nA; cB = nB; ++ui;
        if constexpr (ALIGN_EPI) { if (wr == 1) PG8_BAR; }
    }
    PG8_WAIT_V(0);
    if constexpr (!ALIGN_EPI) { if (wr == 0) PG8_BAR; }
    PG8_BAR;
    if constexpr (Epi::AFTER_DRAIN) { E.fused(acc, cur, wr, wc, fr, fq, lds, wid, lane); S.done(cur); }
#undef PG8_SA
#undef PG8_SB
#undef PG8_STAGE
#undef PG8_LDA
#undef PG8_LDB
#undef PG8_MMA
#undef PG8_WAIT_V
#undef PG8_WAIT_L
#undef PG8_BAR
#undef PG8_SCHED
}
}
#define LAS __attribute__((address_space(3)))
#define GAS __attribute__((address_space(1)))
typedef unsigned short bf16_t;
typedef unsigned v4u __attribute__((ext_vector_type(4)));
typedef unsigned v2u __attribute__((ext_vector_type(2)));
typedef float f32x4 __attribute__((ext_vector_type(4)));
typedef short bf16x8 __attribute__((ext_vector_type(8)));
constexpr int NWAVES = 8, NTHR = 512;
constexpr int DM = 1024, SEQ = 2048, NGRP = 3, BG = 8, MG = BG * SEQ;
constexpr int INW = 7184, NIN = 7168, DFF = 2816, NUP = 2 * DFF, NMEM = 256, MEMR = BG * NMEM;
constexpr float ALPHA = 1.18920711500272f, LN_EPS = 1e-5f;
constexpr size_t MiB = 1u << 20;
constexpr size_t WS_WIN = 1 * MiB, WS_WG = 15 * MiB, WS_WMEM = 16 * MiB, WS_WBM = 18 * MiB, WS_WBA = 19 * MiB, WS_WBC = 21 * MiB, WS_WOUT = 22 * MiB, WS_WUP = 24 * MiB, WS_WDN = 35 * MiB;
constexpr size_t WS_MEMB = 41 * MiB, WS_STATS = 53 * MiB, WS_XN = 54 * MiB;
constexpr size_t WS_QKM = 86 * MiB, WS_VM = 118 * MiB, WS_OM = 134 * MiB, WS_QA = 150 * MiB, WS_KA = 182 * MiB, WS_VA = 190 * MiB, WS_QC = 198 * MiB, WS_GBR = 214 * MiB, WS_GT = 310 * MiB;
constexpr size_t WS_KC = 311 * MiB, WS_VC = 313 * MiB, WS_CT = 315 * MiB, WS_NP = 347 * MiB, WS_MERGED = 348 * MiB, WS_SCR = 380 * MiB, WS_END = 444 * MiB;
constexpr size_t WS_U1 = 86 * MiB, WS_U2 = 174 * MiB, WS_HID = 262 * MiB;
constexpr int LDS_BYTES = 147456, RING_BYTES = 131072, BAR_LDS_OFF = 147456 - 64;
constexpr size_t WS_CTL = 0, WS_ROPE = 65536;
struct Args { const float* in[26]; float* out; unsigned char* ws; };

__device__ __forceinline__ float wave_sum(float v) {
#pragma unroll
    for (int o = 1; o < 64; o <<= 1) v += __shfl_xor(v, o);
    return v;
}
__device__ __forceinline__ unsigned pk2(float lo, float hi) { return pg8::cvt_pk_bf16(lo, hi); }
__device__ __forceinline__ float bflo(unsigned w) { return __uint_as_float(w << 16); }
__device__ __forceinline__ float bfhi(unsigned w) { return __uint_as_float(w & 0xffff0000u); }
#define LDS_WAIT() asm volatile("s_waitcnt lgkmcnt(0)" ::: "memory")

__device__ __forceinline__ void transpose_item(const float* W, int Nsrc, int K, bf16_t* WT, int k0, int n0dst, int n0src, LAS float* scr, int lane) {
#pragma unroll 8
    for (int i = 0; i < 32; ++i) { const int kk = 2 * i + (lane >> 5); scr[kk * 33 + (lane & 31)] = ((const GAS float*)W)[(size_t)(k0 + kk) * Nsrc + n0src + (lane & 31)]; }
    LDS_WAIT(); asm volatile("" ::: "memory");
    const int c = lane & 7;
#pragma unroll
    for (int j = 0; j < 4; ++j) { const int n = (lane >> 3) + 8 * j; const LAS float* s = scr + (8 * c) * 33 + n;
        v4u o; o.x = pk2(s[0 * 33], s[1 * 33]); o.y = pk2(s[2 * 33], s[3 * 33]); o.z = pk2(s[4 * 33], s[5 * 33]); o.w = pk2(s[6 * 33], s[7 * 33]);
        *(GAS v4u*)(WT + (size_t)(n0dst + n) * K + k0 + 8 * c) = o; }
    LDS_WAIT(); asm volatile("" ::: "memory");
}
__device__ __forceinline__ void ln_row(const float* src, const float* g, const float* b, float* of32, bf16_t* obf, float* stats, int lane) {
    const GAS f32x4* xr = (const GAS f32x4*)src + lane;
    f32x4 v[4]; float s = 0.f;
#pragma unroll
    for (int j = 0; j < 4; ++j) { v[j] = xr[64 * j]; s += (v[j].x + v[j].y) + (v[j].z + v[j].w); }
    const float mean = wave_sum(s) * (1.f / DM); float s2 = 0.f;
#pragma unroll
    for (int j = 0; j < 4; ++j) { v[j] = v[j] - mean; s2 += (v[j].x * v[j].x + v[j].y * v[j].y) + (v[j].z * v[j].z + v[j].w * v[j].w); }
    const float rstd = 1.f / sqrtf(wave_sum(s2) * (1.f / DM) + LN_EPS);
    if (stats && lane == 0) { stats[0] = mean; stats[1] = rstd; }
#pragma unroll
    for (int j = 0; j < 4; ++j) { const f32x4 gv = ((const GAS f32x4*)g)[lane + 64 * j], bv = ((const GAS f32x4*)b)[lane + 64 * j];
        const f32x4 o = v[j] * rstd * gv + bv;
        if (of32) ((GAS f32x4*)of32)[lane + 64 * j] = o;
        if (obf) { v2u w; w.x = pk2(o.x, o.y); w.y = pk2(o.z, o.w); ((GAS v2u*)obf)[lane + 64 * j] = w; } }
}
__device__ __forceinline__ void ln_row2(const float* src, const float* g, const float* b, float* of32, bf16_t* obf, float* stats, int lane) {
    const GAS f32x4* xr = (const GAS f32x4*)src + lane;
    f32x4 v[2][4]; float s[2] = {0.f, 0.f};
#pragma unroll
    for (int r = 0; r < 2; ++r)
#pragma unroll
        for (int j = 0; j < 4; ++j) v[r][j] = xr[256 * r + 64 * j];
#pragma unroll
    for (int r = 0; r < 2; ++r)
#pragma unroll
        for (int j = 0; j < 4; ++j) s[r] += (v[r][j].x + v[r][j].y) + (v[r][j].z + v[r][j].w);
    const float mean0 = wave_sum(s[0]) * (1.f / DM), mean1 = wave_sum(s[1]) * (1.f / DM); float q[2] = {0.f, 0.f};
#pragma unroll
    for (int j = 0; j < 4; ++j) { v[0][j] = v[0][j] - mean0; v[1][j] = v[1][j] - mean1;
        q[0] += (v[0][j].x * v[0][j].x + v[0][j].y * v[0][j].y) + (v[0][j].z * v[0][j].z + v[0][j].w * v[0][j].w);
        q[1] += (v[1][j].x * v[1][j].x + v[1][j].y * v[1][j].y) + (v[1][j].z * v[1][j].z + v[1][j].w * v[1][j].w); }
    const float rstd0 = 1.f / sqrtf(wave_sum(q[0]) * (1.f / DM) + LN_EPS), rstd1 = 1.f / sqrtf(wave_sum(q[1]) * (1.f / DM) + LN_EPS);
    if (stats && lane == 0) { stats[0] = mean0; stats[1] = rstd0; stats[2] = mean1; stats[3] = rstd1; }
#pragma unroll
    for (int j = 0; j < 4; ++j) { const f32x4 gv = ((const GAS f32x4*)g)[lane + 64 * j], bv = ((const GAS f32x4*)b)[lane + 64 * j];
        const f32x4 o0 = v[0][j] * rstd0 * gv + bv, o1 = v[1][j] * rstd1 * gv + bv;
        if (of32) { ((GAS f32x4*)of32)[lane + 64 * j] = o0; ((GAS f32x4*)of32)[256 + lane + 64 * j] = o1; }
        if (obf) { v2u w0, w1; w0.x = pk2(o0.x, o0.y); w0.y = pk2(o0.z, o0.w); w1.x = pk2(o1.x, o1.y); w1.y = pk2(o1.z, o1.w);
            ((GAS v2u*)obf)[lane + 64 * j] = w0; ((GAS v2u*)obf)[256 + lane + 64 * j] = w1; } }
}
__device__ __forceinline__ float gelu_tanh(float x) {
    const float u = 0.7978845608028654f * (x + 0.044715f * x * x * x);
    const float e = __expf(2.f * u);
    const float th = 1.f - 2.f * __builtin_amdgcn_rcpf(e + 1.f);
    return 0.5f * x * (1.f + th);
}
#define XB_TMO      128
#define XB_XCNT(j)  (256  + 64 * (j))
#define XB_XSUB(j)  (1280 + 64 * (j))
#define XB_XGEN(j)  (2304 + 64 * (j))
#define XB_TOP      3328
#define XB_TOPGEN   3392
#define XCD_BAR_WORDS 3456
#define XB_SPIN_CAP (1u << 18)

__device__ __forceinline__ unsigned xb_ld(unsigned* p)              { return __hip_atomic_load(p, __ATOMIC_RELAXED, __HIP_MEMORY_SCOPE_AGENT); }
__device__ __forceinline__ unsigned xb_add(unsigned* p, unsigned v) { return __hip_atomic_fetch_add(p, v, __ATOMIC_RELAXED, __HIP_MEMORY_SCOPE_AGENT); }
__device__ __forceinline__ unsigned xb_xcc_id() { return (unsigned)__builtin_amdgcn_s_getreg((3 << 11) | 20) & 0xFu; }
#define XB_SPIN(cond, bar) do { unsigned _sp = 0; while (cond) { __builtin_amdgcn_s_sleep(1); \
    if ((++_sp & 255u) == 0u) { if (xb_ld(&(bar)[XB_TMO])) break; if (_sp > XB_SPIN_CAP) { atomicAdd(&(bar)[XB_TMO], 1u); break; } } } } while (0)

struct XcdBarrier {
    unsigned* bar; unsigned x;
    volatile LAS unsigned* st;
};

__device__ __forceinline__ XcdBarrier xcd_barrier_post(unsigned* bar, volatile LAS unsigned* st) {
    XcdBarrier b; b.bar = bar; b.x = xb_xcc_id(); b.st = st;
    if (threadIdx.x == 0) (void)xb_add(&bar[XB_XCNT(b.x)], 1u);
    return b;
}
__device__ __forceinline__ void xcd_barrier_complete(unsigned* bar, unsigned x, unsigned& nloc, unsigned& nx) {
    const unsigned G = gridDim.x * gridDim.y * gridDim.z;
    unsigned sum, cnt, mine, sp = 0u;
    for (;;) {
        sum = 0u; cnt = 0u; mine = 0u;
#pragma unroll
        for (unsigned j = 0; j < 16; ++j) { const unsigned c = xb_ld(&bar[XB_XCNT(j)]); sum += c; cnt += (c > 0u) ? 1u : 0u; mine = (j == x) ? c : mine; }
        if (sum == G) break;
        __builtin_amdgcn_s_sleep(1);
        if ((++sp & 255u) == 0u) { if (xb_ld(&bar[XB_TMO])) break; if (sp > XB_SPIN_CAP) { atomicAdd(&bar[XB_TMO], 1u); break; } }
    }
    nloc = mine > 0u ? mine : 1u; nx = cnt > 0u ? cnt : 1u;
}

__device__ __forceinline__ void xcd_barrier(const XcdBarrier& b) {
    asm volatile("s_waitcnt vmcnt(0)" ::: "memory");
    __syncthreads();
    if (threadIdx.x == 0) {
        unsigned* bar = b.bar;
        __builtin_amdgcn_s_waitcnt(0);
        unsigned nloc = b.st[0], nx = b.st[1];
        if (nloc == 0u) { xcd_barrier_complete(bar, b.x, nloc, nx); b.st[0] = nloc; b.st[1] = nx; }
        const unsigned old = xb_add(&bar[XB_XSUB(b.x)], 1u);
        const unsigned gen = old / nloc;
        if (old + 1u == (gen + 1u) * nloc) {
            __builtin_amdgcn_fence(__ATOMIC_RELEASE, "agent");
            asm volatile("s_waitcnt vmcnt(0)" ::: "memory");
            const unsigned og = xb_add(&bar[XB_TOP], 1u);
            const unsigned tg = og / nx;
            if (og + 1u == (tg + 1u) * nx) xb_add(&bar[XB_TOPGEN], 1u);
            else XB_SPIN(xb_ld(&bar[XB_TOPGEN]) == tg, bar);
            __builtin_amdgcn_fence(__ATOMIC_ACQUIRE, "agent");
            xb_add(&bar[XB_XGEN(b.x)], 1u);
            asm volatile("s_waitcnt vmcnt(0)" ::: "memory");
        } else {
            XB_SPIN(xb_ld(&bar[XB_XGEN(b.x)]) == gen, bar);
            __builtin_amdgcn_fence(__ATOMIC_ACQUIRE, "agent");
            asm volatile("s_waitcnt vmcnt(0)" ::: "memory");
        }
    }
    __syncthreads();
}
namespace att {
using bf16 = unsigned short;
constexpr int   D = 128, NW = 8, QBLK = 32, KVBLK = 64;
constexpr float SCALE = 0.088388347648318440f;
constexpr float THR = 8.f;
constexpr int SDEPTH = 2;
constexpr size_t SHM_V = KVBLK * D * 2, SHM_K = KVBLK * D * 2, SHM_ATTN = 2 * SHM_V + 2 * SHM_K + NW * 64 * 4;
using bf16x8 = __attribute__((ext_vector_type(8))) short;
using s16x4  = __attribute__((ext_vector_type(4))) short;
using f32x16 = __attribute__((ext_vector_type(16))) float;
using f32x8  = __attribute__((ext_vector_type(8))) float;
using u32x4  = __attribute__((ext_vector_type(4))) unsigned;
#define KSWZ(row, colB) ((row) * 256 + ((colB) ^ (((row) & 7) << 4)))
#define SBAR() __builtin_amdgcn_sched_barrier(0)
__device__ __forceinline__ int crow(int r, int hi) { return (r & 3) + 8 * (r >> 2) + 4 * hi; }
__device__ __forceinline__ unsigned cvtpk(float lo, float hi) {
  unsigned r; asm volatile("v_cvt_pk_bf16_f32 %0, %1, %2" : "=v"(r) : "v"(lo), "v"(hi)); return r;
}
template <typename TIn> struct Stage;
template <> struct Stage<bf16>  { using T = bf16x8;
  __device__ static __forceinline__ T ld8(const bf16* p) { return *reinterpret_cast<const bf16x8*>(p); }
  __device__ static __forceinline__ bf16x8 tobf(T x) { return x; } };
template <> struct Stage<float> { using T = f32x8;
  __device__ static __forceinline__ T ld8(const float* p) { return *reinterpret_cast<const f32x8*>(p); }
  __device__ static __forceinline__ bf16x8 tobf(T x) {
    u32x4 w = {cvtpk(x[0], x[1]), cvtpk(x[2], x[3]), cvtpk(x[4], x[5]), cvtpk(x[6], x[7])}; return *reinterpret_cast<bf16x8*>(&w); } };

__device__ __forceinline__ void partialSM(f32x16& p0, f32x16& p1, float& m_reg, float& mn, float& alpha) {
  constexpr float C = SCALE * 1.4426950408889634f;
  float pmax = p0[0]; for (int r = 1; r < 16; ++r) pmax = fmaxf(pmax, p0[r]); for (int r = 0; r < 16; ++r) pmax = fmaxf(pmax, p1[r]);
  { auto rr = __builtin_amdgcn_permlane32_swap(__float_as_uint(pmax), __float_as_uint(pmax), false, false);
    pmax = fmaxf(__uint_as_float(rr[0]), __uint_as_float(rr[1])); }
  if (__builtin_expect(__all(pmax - m_reg <= THR / SCALE), 1)) { mn = m_reg; alpha = 1.f; }
  else { mn = fmaxf(m_reg, pmax); alpha = __builtin_amdgcn_exp2f((m_reg - mn) * C); m_reg = mn; }
  float mnC = -mn * C;
  for (int r = 0; r < 16; ++r) p0[r] = fmaf(p0[r], C, mnC); for (int r = 0; r < 16; ++r) p1[r] = fmaf(p1[r], C, mnC);
  for (int r = 0; r < 16; ++r) p0[r] = __builtin_amdgcn_exp2f(p0[r]);
}
__device__ __forceinline__ void finishSM(f32x16& p0, f32x16& p1, float alpha, float& l_reg, bf16x8& pa0, bf16x8& pa1, bf16x8& pa2, bf16x8& pa3) {
  for (int r = 0; r < 16; ++r) p1[r] = __builtin_amdgcn_exp2f(p1[r]);
  float ps = 0; for (int r = 0; r < 16; ++r) ps += p0[r]; for (int r = 0; r < 16; ++r) ps += p1[r];
  { auto rr = __builtin_amdgcn_permlane32_swap(__float_as_uint(ps), __float_as_uint(ps), false, false);
    ps = __uint_as_float(rr[0]) + __uint_as_float(rr[1]); }
  l_reg = l_reg * alpha + ps;
#define PK4(P, BASE, OUT) do { unsigned a0 = cvtpk(P[BASE + 0], P[BASE + 1]), a1 = cvtpk(P[BASE + 2], P[BASE + 3]);   \
    unsigned b0 = cvtpk(P[BASE + 4], P[BASE + 5]), b1 = cvtpk(P[BASE + 6], P[BASE + 7]);                              \
    auto r0 = __builtin_amdgcn_permlane32_swap(a0, b0, false, false); auto r1 = __builtin_amdgcn_permlane32_swap(a1, b1, false, false); \
    u32x4 w = {r0[0], r1[0], r0[1], r1[1]}; OUT = *reinterpret_cast<bf16x8*>(&w); } while (0)
  PK4(p0, 0, pa0); PK4(p0, 8, pa1); PK4(p1, 0, pa2); PK4(p1, 8, pa3);
#undef PK4
}
__device__ __forceinline__ void qkt(f32x16& p0, f32x16& p1, const bf16* Ks, const bf16x8* qr, int r32, int hi) {
  p0 = f32x16{}; p1 = f32x16{};
  for (int d0 = 0; d0 < 8; ++d0) { int cb = (d0 * 16 + hi * 8) * 2;
    bf16x8 b0 = *reinterpret_cast<const bf16x8*>((const char*)Ks + KSWZ(r32, cb));
    bf16x8 b1 = *reinterpret_cast<const bf16x8*>((const char*)Ks + KSWZ(32 + r32, cb));
    p0 = __builtin_amdgcn_mfma_f32_32x32x16_bf16(b0, qr[d0], p0, 0, 0, 0);
    p1 = __builtin_amdgcn_mfma_f32_32x32x16_bf16(b1, qr[d0], p1, 0, 0, 0); }
}
__device__ __forceinline__ int v_st(int k, int c) { const int kk = (k & ~0xC) | ((k & 4) << 1) | ((k & 8) >> 1); return ((kk >> 3) * 4 + (c >> 5)) * 512 + ((kk & 7) * 32 + (c & 31)) * 2; }
__device__ __forceinline__ int v_rd_base(int lane) { return ((lane & 3) << 3) | (((lane >> 2) & 3) << 6) | (((lane >> 4) & 1) << 5) | (((lane >> 5) & 1) << 8); }
constexpr int v_rd_off(int d0, int ks, int half) { return d0 * 512 + ks * 4096 + half * 2048; }
template <int OFF> __device__ __forceinline__ s16x4 tr_read(int vb) {
  s16x4 r; asm volatile("ds_read_b64_tr_b16 %0, %1 offset:%2" : "=&v"(r) : "v"(vb), "i"(OFF) : "memory"); return r;
}
template <int D0> __device__ __forceinline__ void pv_one(f32x16& od, int vb, bf16x8 pa0, bf16x8 pa1, bf16x8 pa2, bf16x8 pa3) {
  const s16x4 l0 = tr_read<v_rd_off(D0, 0, 0)>(vb), h0 = tr_read<v_rd_off(D0, 0, 1)>(vb), l1 = tr_read<v_rd_off(D0, 1, 0)>(vb), h1 = tr_read<v_rd_off(D0, 1, 1)>(vb);
  const s16x4 l2 = tr_read<v_rd_off(D0, 2, 0)>(vb), h2 = tr_read<v_rd_off(D0, 2, 1)>(vb), l3 = tr_read<v_rd_off(D0, 3, 0)>(vb), h3 = tr_read<v_rd_off(D0, 3, 1)>(vb);
  asm volatile("s_waitcnt lgkmcnt(0)" ::: "memory"); SBAR();
#define PK(L, H) (bf16x8){L[0], L[1], L[2], L[3], H[0], H[1], H[2], H[3]}
  od = __builtin_amdgcn_mfma_f32_32x32x16_bf16(pa0, PK(l0, h0), od, 0, 0, 0);
  od = __builtin_amdgcn_mfma_f32_32x32x16_bf16(pa1, PK(l1, h1), od, 0, 0, 0);
  od = __builtin_amdgcn_mfma_f32_32x32x16_bf16(pa2, PK(l2, h2), od, 0, 0, 0);
  od = __builtin_amdgcn_mfma_f32_32x32x16_bf16(pa3, PK(l3, h3), od, 0, 0, 0);
#undef PK
}
__device__ __forceinline__ void pv_d0(f32x16* o, int vb, bf16x8 pa0, bf16x8 pa1, bf16x8 pa2, bf16x8 pa3) {
  pv_one<0>(o[0], vb, pa0, pa1, pa2, pa3); pv_one<1>(o[1], vb, pa0, pa1, pa2, pa3); pv_one<2>(o[2], vb, pa0, pa1, pa2, pa3); pv_one<3>(o[3], vb, pa0, pa1, pa2, pa3);
}

template <int LDQ, int LDK>
__device__ __forceinline__ void attn_dense_body(const bf16* Qb, const bf16* __restrict__ Kh, const bf16* __restrict__ Vh,
                                                bf16* Ob, int seq, char* lds) {
  constexpr int LDO = LDQ; using TQ = bf16; using St = Stage<bf16>; using SQ = Stage<TQ>;
  int tid_ = threadIdx.x; asm volatile("" : "+v"(tid_));
  const int tid = tid_, wid = tid >> 6, lane = tid & 63, r32 = lane & 31, hi = lane >> 5;
  bf16* V_lds = (bf16*)lds; bf16* K_lds = (bf16*)(lds + 2 * SHM_V);
  float* ws = (float*)(lds + 2 * SHM_V + 2 * SHM_K) + wid * 64; float* li_l = ws; float* al_l = ws + 32;
  float m_reg = -1e30f, l_reg = 0; f32x16 o[4] = {}; bf16x8 qr[8];
  const TQ* Qw = Qb + (long)(wid * QBLK + r32) * LDQ + hi * 8;
#pragma unroll
  for (int d0 = 0; d0 < 8; ++d0) qr[d0] = SQ::tobf(SQ::ld8(Qw + d0 * 16));
  const int sr = tid >> 4, sc = (tid & 15) * 8, vst0 = v_st(sr, sc), vst1 = v_st(32 + sr, sc);
  const int vb0 = (int)(uintptr_t)V_lds + v_rd_base(lane);
  struct { typename St::T vs0, vs1, ks0, ks1; } sr_[SDEPTH];
#define SLOAD(i, k0) do { sr_[i].vs0 = St::ld8(&Vh[(long)((k0) + sr) * LDK + sc]); sr_[i].vs1 = St::ld8(&Vh[(long)((k0) + 32 + sr) * LDK + sc]); \
    sr_[i].ks0 = St::ld8(&Kh[(long)((k0) + sr) * LDK + sc]); sr_[i].ks1 = St::ld8(&Kh[(long)((k0) + 32 + sr) * LDK + sc]); } while (0)
#define SWRITE(b, i) do { *(bf16x8*)((char*)V_lds + (b) * SHM_V + vst0) = St::tobf(sr_[i].vs0);          \
    *(bf16x8*)((char*)V_lds + (b) * SHM_V + vst1) = St::tobf(sr_[i].vs1); int kc = sc * 2;               \
    *(bf16x8*)((char*)K_lds + (b) * SHM_K + KSWZ(sr, kc)) = St::tobf(sr_[i].ks0);                       \
    *(bf16x8*)((char*)K_lds + (b) * SHM_K + KSWZ(32 + sr, kc)) = St::tobf(sr_[i].ks1); } while (0)
#define SWAIT() do { if constexpr (SDEPTH == 2) asm volatile("s_waitcnt vmcnt(4)" ::: "memory"); else asm volatile("s_waitcnt vmcnt(0)" ::: "memory"); } while (0)
#define RESC(a) do { if (__any((a) < 1.f)) { if (hi == 0) al_l[r32] = (a); asm volatile("s_waitcnt lgkmcnt(0)" ::: "memory"); \
    for (int d = 0; d < 4; ++d) for (int r = 0; r < 16; ++r) o[d][r] *= al_l[crow(r, hi)]; } } while (0)
  f32x16 pA0, pA1, pB0, pB1; float mnA, mnB, alA, alB; bf16x8 pa0, pa1, pa2, pa3; const int NT = seq / KVBLK;
  constexpr int SE = 0, SO = SDEPTH - 1;
  SLOAD(SE, 0); asm volatile("s_waitcnt vmcnt(0)" ::: "memory"); SWRITE(0, SE); __syncthreads();
  qkt(pA0, pA1, K_lds, qr, r32, hi); partialSM(pA0, pA1, m_reg, mnA, alA);
  SLOAD(SO, KVBLK); if constexpr (SDEPTH == 2) { if (2 < NT) SLOAD(SE, 2 * KVBLK); }
  SWAIT(); SWRITE(1, SO); __syncthreads();
  for (int j = 1; j + 1 < NT; j += 2) {
    SBAR(); qkt(pB0, pB1, (bf16*)((char*)K_lds + SHM_K), qr, r32, hi);
    finishSM(pA0, pA1, alA, l_reg, pa0, pa1, pa2, pa3); SBAR();
    SLOAD(SO, (j + SDEPTH) * KVBLK); SBAR();
    pv_d0(o, vb0, pa0, pa1, pa2, pa3); partialSM(pB0, pB1, m_reg, mnB, alB);
    __syncthreads(); SWAIT(); SWRITE(0, SE);
    RESC(alB); __syncthreads();
    SBAR(); qkt(pA0, pA1, K_lds, qr, r32, hi);
    finishSM(pB0, pB1, alB, l_reg, pa0, pa1, pa2, pa3); SBAR();
    if (SDEPTH == 1 || j + 3 < NT) SLOAD(SE, (j + 1 + SDEPTH) * KVBLK); SBAR();
    pv_d0(o, vb0 + (int)SHM_V, pa0, pa1, pa2, pa3); partialSM(pA0, pA1, m_reg, mnA, alA);
    __syncthreads(); SWAIT(); SWRITE(1, SO);
    RESC(alA); __syncthreads();
  }
  SBAR(); qkt(pB0, pB1, (bf16*)((char*)K_lds + SHM_K), qr, r32, hi);
  finishSM(pA0, pA1, alA, l_reg, pa0, pa1, pa2, pa3); SBAR();
  pv_d0(o, vb0, pa0, pa1, pa2, pa3); partialSM(pB0, pB1, m_reg, mnB, alB);
  __syncthreads(); RESC(alB);
  finishSM(pB0, pB1, alB, l_reg, pa0, pa1, pa2, pa3); SBAR();
  pv_d0(o, vb0 + (int)SHM_V, pa0, pa1, pa2, pa3);
  if (hi == 0) li_l[r32] = l_reg; asm volatile("s_waitcnt lgkmcnt(0)" ::: "memory");
  float rli[16];
#pragma unroll
  for (int r = 0; r < 16; ++r) rli[r] = __builtin_amdgcn_rcpf(li_l[crow(r, hi)]);
  bf16* Ow = Ob + (long)(wid * QBLK) * LDO;
#pragma unroll
  for (int r = 0; r < 16; ++r) { int orow = crow(r, hi);
    for (int d0 = 0; d0 < 4; ++d0) Ow[(long)orow * LDO + d0 * 32 + r32] = (bf16)(cvtpk(o[d0][r] * rli[r], 0.f) & 0xffffu); }
  __syncthreads();
#undef SLOAD
#undef SWRITE
#undef SWAIT
#undef RESC
}

}
namespace ml {
using att::bf16x8; using att::s16x4; using att::f32x16; using att::u32x4;
constexpr float DKS = 0.08838834764831845f;
constexpr int ML_KT = 0, ML_VT = 32768, ML_WA = 65536, ML_SM = 73728;
constexpr int M3_K = 0, M3_V = 32768, M3_CF = 65536, M3_CB = 98304, M3_X = 131072;
__device__ __forceinline__ float wscan_add(float v, int lane) {
#pragma unroll
    for (int o = 1; o < 64; o <<= 1) { const float t = __shfl_up(v, o); if (lane >= o) v += t; }
    return v; }
__device__ __forceinline__ float wscan_max(float v, int lane) {
#pragma unroll
    for (int o = 1; o < 64; o <<= 1) { const float t = __shfl_up(v, o); if (lane >= o) v = fmaxf(v, t); }
    return v; }
__device__ __forceinline__ float wrscan_max(float v, int lane) {
#pragma unroll
    for (int o = 1; o < 64; o <<= 1) { const float t = __shfl_down(v, o); if (lane + o < 64) v = fmaxf(v, t); }
    return v; }
__device__ __forceinline__ float wave_max(float v) {
#pragma unroll
    for (int o = 1; o < 64; o <<= 1) v = fmaxf(v, __shfl_xor(v, o));
    return v; }
__device__ __forceinline__ float logsig(float f) { return fminf(f, 0.f) - log1pf(expf(-fabsf(f))); }
__device__ __forceinline__ void conv_silu8(const bf16_t* p, int t, const float (&w)[3][8], const float (&b)[8], float (&o)[8]) {
    const v4u z = {0u, 0u, 0u, 0u};
    const v4u c = *(const GAS v4u*)p;
    const v4u a = (t > 0) ? *(const GAS v4u*)(p - 1024) : z;
    const v4u n = (t < SEQ - 1) ? *(const GAS v4u*)(p + 1024) : z;
#pragma unroll
    for (int q = 0; q < 4; ++q) {
        const float yl = w[0][2 * q] * bflo(a[q]) + w[1][2 * q] * bflo(c[q]) + w[2][2 * q] * bflo(n[q]) + b[2 * q];
        const float yh = w[0][2 * q + 1] * bfhi(a[q]) + w[1][2 * q + 1] * bfhi(c[q]) + w[2][2 * q + 1] * bfhi(n[q]) + b[2 * q + 1];
        o[2 * q] = yl * pg8::sigm(yl); o[2 * q + 1] = yh * pg8::sigm(yh); }
}
__device__ __forceinline__ void ld_convw(const float* cw, const float* cb, int col, float (&w)[3][8], float (&b)[8]) {
#pragma unroll
    for (int j = 0; j < 3; ++j)
#pragma unroll
        for (int e = 0; e < 8; ++e) w[j][e] = cw[j * 1024 + col + e];
#pragma unroll
    for (int e = 0; e < 8; ++e) b[e] = cb[col + e];
}
__device__ __forceinline__ bf16x8 pack8(const float (&o)[8], float s) {
    u32x4 w = {att::cvtpk(o[0] * s, o[1] * s), att::cvtpk(o[2] * s, o[3] * s), att::cvtpk(o[4] * s, o[5] * s), att::cvtpk(o[6] * s, o[7] * s)};
    return *reinterpret_cast<bf16x8*>(&w); }
#define ML_PK(L, H) (bf16x8){L[0], L[1], L[2], L[3], H[0], H[1], H[2], H[3]}

__device__ __forceinline__ void conv_silu8r(const v4u a, const v4u c, const v4u n, const float (&w)[3][8], const float (&b)[8], float (&o)[8]) {
#pragma unroll
    for (int q = 0; q < 4; ++q) {
        const float yl = w[0][2 * q] * bflo(a[q]) + w[1][2 * q] * bflo(c[q]) + w[2][2 * q] * bflo(n[q]) + b[2 * q];
        const float yh = w[0][2 * q + 1] * bfhi(a[q]) + w[1][2 * q + 1] * bfhi(c[q]) + w[2][2 * q + 1] * bfhi(n[q]) + b[2 * q + 1];
        o[2 * q] = yl * pg8::sigm(yl); o[2 * q + 1] = yh * pg8::sigm(yh); }
}
__device__ __forceinline__ void scan_item(const bf16_t* QKM, const bf16_t* VM, const float* GT, const float* cw, const float* cb, bf16_t* CT, float* NP, float* MP,
                                          int b, int h, int dir, int dkh, char* lds) {
    int tid_ = threadIdx.x; asm volatile("" : "+v"(tid_));
    const int tid = tid_, wid = tid >> 6, lane = tid & 63, hi = lane >> 5;
    float* WA = (float*)(lds + ML_WA); float* SM = (float*)(lds + ML_SM);
#pragma unroll
    for (int cc = 0; cc < 2; ++cc) {
        const int c = 2 * wid + cc, s0 = 128 * c + 2 * lane; const float* gp = GT + (size_t)(b * SEQ + s0) * 16 + 8 * dir + h;
        const float li0 = gp[0], li1 = gp[16], lf0 = logsig(gp[4]), lf1 = logsig(gp[20]);
        const float s = lf0 + lf1, incl = wscan_add(s, lane), bl1 = incl, bl0 = incl - lf1, gtot = __shfl(incl, 63);
        float a0, a1;
        if (dir == 0) { a0 = gtot - bl0 + li0; a1 = gtot - bl1 + li1; } else { a0 = bl0 - lf0 + li0; a1 = bl1 - lf1 + li1; }
        const float ma = wave_max(fmaxf(a0, a1));
        WA[s0] = expf(a0 - ma); WA[s0 + 1] = expf(a1 - ma);
        if (lane == 0) { SM[c] = gtot; SM[16 + c] = ma; }
    }
    __syncthreads();
    if (tid == 0) { float m = 0.f;
        for (int k = 0; k < 16; ++k) { const int c = dir ? 15 - k : k; const float gc = SM[c], ma = SM[16 + c], mn = fmaxf(gc + m, ma);
            SM[64 + c] = m; SM[32 + c] = expf(gc + m - mn); SM[48 + c] = expf(ma - mn); m = mn; } }
    __syncthreads();
    const int al = wid >> 2, d = wid & 3;
    f32x16 acc = {}, nacc = {};
    const int sr = tid >> 4, sc = (tid & 15) * 8, vst0 = att::v_st(sr, sc), vst1 = att::v_st(32 + sr, sc);
    const int ktok = tid >> 3, kcol = (tid & 7) * 8, kst = att::v_st(ktok, kcol);
    const int lbase = (int)(uintptr_t)lds;
    const int vbK = lbase + ML_KT + att::v_rd_base(lane) + al * 512, vbV = lbase + ML_VT + att::v_rd_base(lane) + d * 512;
    float w[3][8], bb[8]; ld_convw(cw, cb, 512 + h * 128 + dkh * 64 + kcol, w, bb);
    const bf16x8 ones = {0x3F80, 0x3F80, 0x3F80, 0x3F80, 0x3F80, 0x3F80, 0x3F80, 0x3F80};
    const size_t idx0 = (size_t)((b * 4 + h) * 2 + dir) * 16;
    const bf16_t* kbase = QKM + (size_t)b * SEQ * 1024 + 512 + h * 128 + dkh * 64 + kcol; const bf16_t* vbase = VM + (size_t)b * SEQ * 512 + h * 128 + sc;
    v4u kr[2][3]; bf16x8 vr[4]; const v4u z4 = {0u, 0u, 0u, 0u};
#define ML_LOADCHUNK(C) do { _Pragma("unroll") for (int i = 0; i < 2; ++i) { const int t = 128 * (C) + 64 * i + ktok; const bf16_t* p = kbase + (size_t)t * 1024; \
        kr[i][1] = *(const GAS v4u*)p; kr[i][0] = (t > 0) ? *(const GAS v4u*)(p - 1024) : z4; kr[i][2] = (t < SEQ - 1) ? *(const GAS v4u*)(p + 1024) : z4; } \
      _Pragma("unroll") for (int i = 0; i < 4; ++i) vr[i] = *(const GAS bf16x8*)(vbase + (size_t)(128 * (C) + 32 * i + sr) * 512); } while (0)
    ML_LOADCHUNK(dir ? 15 : 0);
    for (int k = 0; k < 16; ++k) {
        const int c = dir ? 15 - k : k; const size_t idx = idx0 + c;
        { const float scs = SM[48 + c] * DKS;
#pragma unroll
          for (int i = 0; i < 2; ++i) { float o[8]; conv_silu8r(kr[i][0], kr[i][1], kr[i][2], w, bb, o);
              *(bf16x8*)(lds + ML_KT + i * 16384 + kst) = pack8(o, scs * WA[128 * c + 64 * i + ktok]); }
#pragma unroll
          for (int i = 0; i < 4; ++i) *(bf16x8*)(lds + ML_VT + (i >> 1) * 16384 + ((i & 1) ? vst1 : vst0)) = vr[i]; }
        if (k < 15) { const int cn = dir ? 14 - k : k + 1; ML_LOADCHUNK(cn); }
        { bf16_t* ct = CT + idx * 16384; const int cl = lane & 31;
#pragma unroll
          for (int q = 0; q < 4; ++q) { const int dk = 64 * dkh + 32 * al + 8 * q + 4 * hi;
              v2u o0; o0.x = att::cvtpk(acc[4 * q], acc[4 * q + 1]); o0.y = att::cvtpk(acc[4 * q + 2], acc[4 * q + 3]);
              *(GAS v2u*)(ct + (32 * d + cl) * 128 + dk) = o0; }
          if (d == 0 && cl == 0) {
#pragma unroll
              for (int r = 0; r < 16; ++r) NP[idx * 128 + 64 * dkh + 32 * al + att::crow(r, hi)] = nacc[r]; }
          if (tid == 0 && dkh == 0) MP[idx] = SM[64 + c];
          const float sp = SM[32 + c];
#pragma unroll
          for (int r = 0; r < 16; ++r) { acc[r] *= sp; nacc[r] *= sp; } }
        __syncthreads();
#define ML_STEP(OFF) { const s16x4 kl = att::tr_read<(OFF)>(vbK), kh = att::tr_read<(OFF) + 2048>(vbK); \
            const s16x4 vl = att::tr_read<(OFF)>(vbV), vh = att::tr_read<(OFF) + 2048>(vbV); \
            asm volatile("s_waitcnt lgkmcnt(0)" ::: "memory"); __builtin_amdgcn_sched_barrier(0); \
            const bf16x8 ka = ML_PK(kl, kh); \
            acc = __builtin_amdgcn_mfma_f32_32x32x16_bf16(ka, ML_PK(vl, vh), acc, 0, 0, 0); \
            nacc = __builtin_amdgcn_mfma_f32_32x32x16_bf16(ka, ones, nacc, 0, 0, 0); }
        ML_STEP(0) ML_STEP(4096) ML_STEP(8192) ML_STEP(12288) ML_STEP(16384) ML_STEP(16384 + 4096) ML_STEP(16384 + 8192) ML_STEP(16384 + 12288)
#undef ML_STEP
        __syncthreads();
    }
#undef ML_LOADCHUNK
}

__device__ __forceinline__ void out_unit(const bf16_t* QKM, const bf16_t* VM, const bf16_t* OM, bf16_t* HM, const float* GT, const float* cw, const float* cb, const float* ng,
                                         const bf16_t* CT, const float* NP, const float* MP, int b, int h, int c, char* lds) {
    int tid_ = threadIdx.x; asm volatile("" : "+v"(tid_));
    const int tid = tid_, wid = tid >> 6, lane = tid & 63, r32 = lane & 31, hi = lane >> 5;
    float* XA = (float*)(lds + M3_X);
    const size_t row0 = (size_t)b * SEQ + 128 * c;
    if (wid < 2) { const int dir = wid; const size_t idx = (size_t)((b * 4 + h) * 2 + dir) * 16 + c; const float mprev = MP[idx];
        const float* gp = GT + (row0 + 2 * lane) * 16 + 8 * dir + h;
        const float li0 = gp[0], li1 = gp[16], lf0 = logsig(gp[4]), lf1 = logsig(gp[20]);
        const float incl = wscan_add(lf0 + lf1, lane), bl1 = incl, bl0 = incl - lf1, gtot = __shfl(incl, 63);
        float x0, x1, a0, a1, p0, p1;
        if (dir == 0) { x0 = bl0; x1 = bl1; a0 = li0 - x0; a1 = li1 - x1;
            const float ps = wscan_max(fmaxf(a0, a1), lane); float ex = __shfl_up(ps, 1); if (lane == 0) ex = -INFINITY; p0 = fmaxf(a0, ex); p1 = fmaxf(a1, p0); }
        else { x0 = gtot - bl0 + lf0; x1 = gtot - bl1 + lf1; a0 = li0 - x0; a1 = li1 - x1;
            const float ps = wrscan_max(fmaxf(a0, a1), lane); float ex = __shfl_down(ps, 1); if (lane == 63) ex = -INFINITY; p1 = fmaxf(a1, ex); p0 = fmaxf(a0, p1); }
        float* X = XA + dir * 128;
        X[2 * lane] = a0; X[2 * lane + 1] = a1; X[256 + 2 * lane] = fmaxf(mprev, p0); X[256 + 2 * lane + 1] = fmaxf(mprev, p1);
        X[512 + 2 * lane] = x0; X[512 + 2 * lane + 1] = x1;
        X[768 + 2 * lane] = NP[idx * 128 + 2 * lane]; X[768 + 2 * lane + 1] = NP[idx * 128 + 2 * lane + 1];
    }
    { const int sr = tid >> 4, sc = (tid & 15) * 8, kc = sc * 2;
      float w[3][8], bb[8]; ld_convw(cw, cb, 512 + h * 128 + sc, w, bb);
      const bf16_t* ctf = CT + ((size_t)((b * 4 + h) * 2 + 0) * 16 + c) * 16384; const bf16_t* ctb = CT + ((size_t)((b * 4 + h) * 2 + 1) * 16 + c) * 16384;
#pragma unroll
      for (int tl = 0; tl < 2; ++tl)
#pragma unroll
          for (int hf = 0; hf < 2; ++hf) { const int rl = 32 * hf + sr, sl = 64 * tl + rl, t = 128 * c + sl; const size_t row = (size_t)b * SEQ + t;
              float o[8]; conv_silu8(QKM + row * 1024 + 512 + h * 128 + sc, t, w, bb, o);
              *(bf16x8*)(lds + M3_K + tl * 16384 + KSWZ(rl, kc)) = pack8(o, DKS);
              *(bf16x8*)(lds + M3_V + tl * 16384 + att::v_st(rl, sc)) = *(const GAS bf16x8*)(VM + row * 512 + h * 128 + sc);
              *(bf16x8*)(lds + M3_CF + tl * 16384 + KSWZ(rl, kc)) = *(const GAS bf16x8*)(ctf + sl * 128 + sc);
              *(bf16x8*)(lds + M3_CB + tl * 16384 + KSWZ(rl, kc)) = *(const GAS bf16x8*)(ctb + sl * 128 + sc); } }
    const int dir = wid >> 2, tq = 32 * (wid & 3) + r32;
    bf16x8 qr[8];
    { const int t = 128 * c + tq; const bf16_t* qp = QKM + (row0 + tq) * 1024 + h * 128 + hi * 8;
#pragma unroll
      for (int d0 = 0; d0 < 8; ++d0) { float w[3][8], bb[8], o[8]; ld_convw(cw, cb, h * 128 + hi * 8 + 16 * d0, w, bb); conv_silu8(qp + 16 * d0, t, w, bb, o); qr[d0] = pack8(o, 1.f); } }
    __syncthreads();
    const float* X = XA + dir * 128;
    const float Mt = X[256 + tq], winter = __expf(MP[(size_t)((b * 4 + h) * 2 + dir) * 16 + c] - Mt), flo = __expf(-(X[512 + tq] + Mt));
    f32x16 o[4] = {}; float den = 0.f;
    const int vb0 = (int)(uintptr_t)lds + M3_V + att::v_rd_base(lane);
#pragma unroll
    for (int tl = 0; tl < 2; ++tl) {
        f32x16 p0, p1; att::qkt(p0, p1, (const att::bf16*)(lds + M3_K + tl * 16384), qr, r32, hi);
#pragma unroll
        for (int r = 0; r < 16; ++r) { const int s0 = 64 * tl + att::crow(r, hi), s1 = s0 + 32;
            const bool k0 = dir ? (s0 >= tq) : (s0 <= tq), k1 = dir ? (s1 >= tq) : (s1 <= tq);
            const float w0 = k0 ? __expf(fminf(X[s0] - Mt, 0.f)) : 0.f, w1 = k1 ? __expf(fminf(X[s1] - Mt, 0.f)) : 0.f;
            p0[r] *= w0; p1[r] *= w1; den += p0[r] + p1[r]; }
        bf16x8 pa0, pa1, pa2, pa3;
#define PK4(P, BASE, OUT) do { unsigned a0 = att::cvtpk(P[BASE + 0], P[BASE + 1]), a1 = att::cvtpk(P[BASE + 2], P[BASE + 3]);   \
    unsigned b0 = att::cvtpk(P[BASE + 4], P[BASE + 5]), b1 = att::cvtpk(P[BASE + 6], P[BASE + 7]);                              \
    auto r0 = __builtin_amdgcn_permlane32_swap(a0, b0, false, false); auto r1 = __builtin_amdgcn_permlane32_swap(a1, b1, false, false); \
    u32x4 w = {r0[0], r1[0], r0[1], r1[1]}; OUT = *reinterpret_cast<bf16x8*>(&w); } while (0)
        PK4(p0, 0, pa0); PK4(p0, 8, pa1); PK4(p1, 0, pa2); PK4(p1, 8, pa3);
#undef PK4
        att::pv_d0(o, vb0 + tl * 16384, pa0, pa1, pa2, pa3);
    }
    { auto rr = __builtin_amdgcn_permlane32_swap(__float_as_uint(den), __float_as_uint(den), false, false); den = __uint_as_float(rr[0]) + __uint_as_float(rr[1]); }
    { float dn = 0.f; const float* NPV = X + 768;
      const char* ctl = lds + (dir ? M3_CB : M3_CF);
#pragma unroll
      for (int kc = 0; kc < 8; ++kc) { const u32x4 qw = *reinterpret_cast<const u32x4*>(&qr[kc]); float qf[8] = {bflo(qw.x), bfhi(qw.x), bflo(qw.y), bfhi(qw.y), bflo(qw.z), bfhi(qw.z), bflo(qw.w), bfhi(qw.w)};
#pragma unroll
          for (int e = 0; e < 8; ++e) { dn += qf[e] * NPV[16 * kc + 8 * hi + e]; }
          const bf16x8 qs = pack8(qf, winter); const int cb2 = (16 * kc + 8 * hi) * 2;
#pragma unroll
          for (int d0 = 0; d0 < 4; ++d0) { const int rw = 32 * (d0 & 1) + r32;
              const bf16x8 cf = *(const bf16x8*)(ctl + (d0 >> 1) * 16384 + KSWZ(rw, cb2));
              o[d0] = __builtin_amdgcn_mfma_f32_32x32x16_bf16(qs, cf, o[d0], 0, 0, 0); } }
      { auto rr = __builtin_amdgcn_permlane32_swap(__float_as_uint(dn), __float_as_uint(dn), false, false); dn = __uint_as_float(rr[0]) + __uint_as_float(rr[1]); }
      den += winter * dn; }
    const float inv = 1.f / fmaxf(fabsf(den), flo);
    float* wsx = XA + 1024 + wid * 32;
    if (hi == 0) wsx[r32] = inv;
    asm volatile("s_waitcnt lgkmcnt(0)" ::: "memory");
    float rinv[16];
#pragma unroll
    for (int r = 0; r < 16; ++r) rinv[r] = wsx[att::crow(r, hi)];
    __syncthreads();
    float* H = (float*)lds;
    if (dir == 1) {
#pragma unroll
        for (int r = 0; r < 16; ++r) { const int t = 32 * (wid & 3) + att::crow(r, hi);
#pragma unroll
            for (int d0 = 0; d0 < 4; ++d0) H[t * 132 + 32 * d0 + r32] = o[d0][r] * rinv[r]; } }
    __syncthreads();
    if (dir == 0) {
#pragma unroll
        for (int r = 0; r < 16; ++r) { const int t = 32 * (wid & 3) + att::crow(r, hi);
#pragma unroll
            for (int d0 = 0; d0 < 4; ++d0) H[t * 132 + 32 * d0 + r32] += o[d0][r] * rinv[r]; } }
    __syncthreads();
    { const int t = tid >> 2, sg = tid & 3; const float* hp = H + t * 132 + 32 * sg; float v[32]; float s = 0.f;
#pragma unroll
      for (int e = 0; e < 32; ++e) { v[e] = hp[e]; s += v[e]; }
      s += __shfl_xor(s, 1); s += __shfl_xor(s, 2); const float mean = s * (1.f / 128.f); float q = 0.f;
#pragma unroll
      for (int e = 0; e < 32; ++e) { v[e] -= mean; q += v[e] * v[e]; }
      q += __shfl_xor(q, 1); q += __shfl_xor(q, 2); const float rstd = 1.f / sqrtf(q * (1.f / 128.f) + LN_EPS);
      const bf16_t* op = OM + (row0 + t) * 512 + h * 128 + 32 * sg; bf16_t* hp2 = HM + (row0 + t) * 512 + h * 128 + 32 * sg; const float* gp = ng + h * 128 + 32 * sg;
#pragma unroll
      for (int e8 = 0; e8 < 4; ++e8) { const v4u sw = *(const GAS v4u*)(op + 8 * e8);
          const float sg8[8] = {bflo(sw.x), bfhi(sw.x), bflo(sw.y), bfhi(sw.y), bflo(sw.z), bfhi(sw.z), bflo(sw.w), bfhi(sw.w)}; float ov[8];
#pragma unroll
          for (int e = 0; e < 8; ++e) ov[e] = v[8 * e8 + e] * rstd * gp[8 * e8 + e] * sg8[e];
          v4u r; r.x = pk2(ov[0], ov[1]); r.y = pk2(ov[2], ov[3]); r.z = pk2(ov[4], ov[5]); r.w = pk2(ov[6], ov[7]);
          *(GAS v4u*)(hp2 + 8 * e8) = r; } }
    __syncthreads();
}
}
#define REPEAT_1(...) __VA_ARGS__
#define REPEAT_2(...) __VA_ARGS__ __syncthreads(); __builtin_amdgcn_sched_barrier(0); asm volatile("s_nop 0" ::: "memory"); __VA_ARGS__
#define REPEAT_X(n, ...) REPEAT_##n(__VA_ARGS__)
#define REPEAT(n, ...) REPEAT_X(n, __VA_ARGS__)
#ifndef REP_OUT
#define REP_OUT 1
#endif
#ifndef REP_P1
#define REP_P1 1
#endif
#ifndef REP_SCAN
#define REP_SCAN 1
#endif
#ifndef REP_P4
#define REP_P4 1
#endif
#ifndef REP_P5
#define REP_P5 1
#endif
#ifndef REP_P6
#define REP_P6 1
#endif
#ifndef REP_CONV
#define REP_CONV 1
#endif
#ifndef MIX_MLSTM
#define MIX_MLSTM 0
#endif
#ifndef MIX_GQA
#define MIX_GQA 0
#endif
__device__ __forceinline__ void gates_unit(const bf16_t* XN, const bf16_t* WgT, const float* bias, float* GT, int t, int wave, int lane) {
    const int fr = lane & 15, fq = lane >> 4;
    const f32x4 bv = *(const GAS f32x4*)(bias + 4 * fq);
    const GAS bf16x8* bp = (const GAS bf16x8*)(WgT + fr * 1024 + 8 * fq);
#pragma unroll
    for (int blk = 0; blk < 2; ++blk) {
        const int row = 256 * t + 32 * wave + 16 * blk + fr;
        const GAS bf16x8* ap = (const GAS bf16x8*)(XN + (size_t)row * 1024 + 8 * fq);
        f32x4 acc = {0.f, 0.f, 0.f, 0.f};
#pragma unroll 8
        for (int k = 0; k < 32; ++k) acc = __builtin_amdgcn_mfma_f32_16x16x32_bf16(bp[4 * k], ap[4 * k], acc, 0, 0, 0);
        *(GAS f32x4*)(GT + (size_t)row * 16 + 4 * fq) = acc + bv;
    }
}

__device__ __forceinline__ void qk_norm_rope(bf16_t* QA, bf16_t* KA, const float* gq, const float* gk, const float* rope, int idx, int cnt) {
    const int j = idx & 15; constexpr int NP = MG * 8 + MG * 2;
    for (int p = idx >> 4; p < NP; p += cnt >> 4) {
        int row; bf16_t* ptr; const float* gp;
        if (p < MG * 8) { row = p >> 3; ptr = QA + (size_t)row * 1024 + (p & 7) * 128 + 8 * j; gp = gq; }
        else { const int q = p - MG * 8; row = q >> 1; ptr = KA + (size_t)row * 256 + (q & 1) * 128 + 8 * j; gp = gk; }
        const v4u w = *(const GAS v4u*)ptr;
        float x[8] = {bflo(w.x), bfhi(w.x), bflo(w.y), bfhi(w.y), bflo(w.z), bfhi(w.z), bflo(w.w), bfhi(w.w)};
        float ss = 0.f;
#pragma unroll
        for (int e = 0; e < 8; ++e) ss += x[e] * x[e];
        ss += __shfl_xor(ss, 1); ss += __shfl_xor(ss, 2); ss += __shfl_xor(ss, 4); ss += __shfl_xor(ss, 8);
        const float rs = 1.f / sqrtf(ss * (1.f / 128.f) + LN_EPS);
        const int t = row & (SEQ - 1); const int pos = (j < 8) ? (t >> 6) : (t & 63);
        const bool second = (j & 4) != 0;
        const GAS f32x4* tb = (const GAS f32x4*)(rope + (size_t)(pos * 32 + 8 * (j & 3)) * 2);
        float o[8];
#pragma unroll
        for (int e2 = 0; e2 < 4; ++e2) { const f32x4 cssn = tb[e2];
#pragma unroll
            for (int k = 0; k < 2; ++k) { const int e = 2 * e2 + k; const float cs = cssn[2 * k], sn = cssn[2 * k + 1];
                const float xe = x[e] * rs * gp[8 * j + e];
                const float other = __shfl_xor(xe, 4);
                o[e] = second ? (xe * cs + other * sn) : (xe * cs - other * sn); } }
        v4u r; r.x = pk2(o[0], o[1]); r.y = pk2(o[2], o[3]); r.z = pk2(o[4], o[5]); r.w = pk2(o[6], o[7]);
        *(GAS v4u*)ptr = r;
    }
}

__device__ __forceinline__ void mixer_phases(const Args& a, unsigned char* lds_raw, int g, const XcdBarrier& grid, int tid, int bx, int G) {
    LAS unsigned char* lds = (LAS unsigned char*)lds_raw;
    const int lane = tid & 63, wave = __builtin_amdgcn_readfirstlane(tid >> 6);
    unsigned char* ws = a.ws;
    bf16_t* XN = (bf16_t*)(ws + WS_XN);
    {
        pg8::Gemm gm{XN, (const bf16_t*)(ws + WS_WIN), MG, NIN, DM}; pg8::StaticOrder S; S.init(MG, NIN, G, bx);
        pg8::EpiInProj E{(bf16_t*)(ws + WS_QKM), (bf16_t*)(ws + WS_VM), (bf16_t*)(ws + WS_OM), (bf16_t*)(ws + WS_QA), (bf16_t*)(ws + WS_KA), (bf16_t*)(ws + WS_VA), (bf16_t*)(ws + WS_QC), (bf16_t*)(ws + WS_GBR)};
        REPEAT(REP_P1, pg8::gemm_phase<pg8::EpiInProj, pg8::StaticOrder, true, true>(lds, gm, S, E);)
        for (int t = bx; t < MG / 256; t += G) gates_unit(XN, (const bf16_t*)(ws + WS_WG), a.in[7], (float*)(ws + WS_GT), t, wave, lane);
    }
    xcd_barrier(grid);
    {
        const int c = bx >= 128 ? bx - 128 : 1 << 20;
        pg8::Gemm gm{(const bf16_t*)(ws + WS_MEMB) + (size_t)g * MEMR * DM, (const bf16_t*)(ws + WS_WMEM), MEMR, 1024, DM}; pg8::StaticOrder S; S.init(MEMR, 1024, 64, c);
        pg8::EpiSplit E{(bf16_t*)(ws + WS_KC), 512, 512, (WS_VC - WS_KC) / 2};
        pg8::gemm_phase<pg8::EpiSplit, pg8::StaticOrder, true, true>(lds, gm, S, E);
#if MIX_MLSTM
        REPEAT(REP_SCAN, if (bx < 128) ml::scan_item((const bf16_t*)(ws + WS_QKM), (const bf16_t*)(ws + WS_VM), (const float*)(ws + WS_GT), a.in[8], a.in[9],
                                    (bf16_t*)(ws + WS_CT), (float*)(ws + WS_NP), (float*)(ws + WS_NP) + 1024 * 128, bx >> 4, (bx >> 2) & 3, (bx >> 1) & 1, bx & 1, (char*)lds_raw);)
#endif
#if MIX_GQA
        qk_norm_rope((bf16_t*)(ws + WS_QA), (bf16_t*)(ws + WS_KA), a.in[11], a.in[12], (const float*)(ws + WS_ROPE), bx * NTHR + tid, G * NTHR);
#endif
    }
    xcd_barrier(grid);
    {
#if MIX_GQA
        { const int vcu = (G % 8 == 0) ? (bx % 8) * (G / 8) + bx / 8 : bx;
          for (int u = vcu; u < BG * 8 * 8; u += G) {
            const int b = u >> 6, h = (u >> 3) & 7, qb = u & 7;
            att::bf16* Q = (att::bf16*)(ws + WS_QA) + (size_t)(b * SEQ + qb * 256) * 1024 + h * 128;
            const att::bf16* K = (const att::bf16*)(ws + WS_KA) + (size_t)(b * SEQ) * 256 + (h >> 2) * 128;
            const att::bf16* V = (const att::bf16*)(ws + WS_VA) + (size_t)(b * SEQ) * 256 + (h >> 2) * 128;
            att::attn_dense_body<1024, 256>(Q, K, V, Q, SEQ, (char*)lds_raw);
          } }
#endif
#if MIX_MLSTM
#if REP_OUT > 1
        for (int u = bx; u < BG * 4 * 16; u += G)
            ml::out_unit((const bf16_t*)(ws + WS_QKM), (const bf16_t*)(ws + WS_VM), (const bf16_t*)(ws + WS_OM), (bf16_t*)(ws + WS_SCR), (const float*)(ws + WS_GT), a.in[8], a.in[9], a.in[10],
                         (const bf16_t*)(ws + WS_CT), (const float*)(ws + WS_NP), (const float*)(ws + WS_NP) + 1024 * 128, u >> 6, (u >> 4) & 3, u & 15, (char*)lds_raw);
#endif
        for (int u = bx; u < BG * 4 * 16; u += G)
            ml::out_unit((const bf16_t*)(ws + WS_QKM), (const bf16_t*)(ws + WS_VM), (const bf16_t*)(ws + WS_OM), (bf16_t*)(ws + WS_OM), (const float*)(ws + WS_GT), a.in[8], a.in[9], a.in[10],
                         (const bf16_t*)(ws + WS_CT), (const float*)(ws + WS_NP), (const float*)(ws + WS_NP) + 1024 * 128, u >> 6, (u >> 4) & 3, u & 15, (char*)lds_raw);
#endif
        for (int u = bx; u < BG * 4 * 8; u += G) {
            const int b = u >> 5, h = (u >> 3) & 3, qb = u & 7;
            att::bf16* Q = (att::bf16*)(ws + WS_QC) + (size_t)(b * SEQ + qb * 256) * 512 + h * 128;
            const att::bf16* K = (const att::bf16*)(ws + WS_KC) + (size_t)(b * NMEM) * 512 + h * 128;
            const att::bf16* V = (const att::bf16*)(ws + WS_VC) + (size_t)(b * NMEM) * 512 + h * 128;
            att::attn_dense_body<512, 512>(Q, K, V, Q, NMEM, (char*)lds_raw);
        }
    }
    xcd_barrier(grid);
    {
        pg8::StaticOrder S; S.init(MG, DM, G, bx);
        {
        float* SCR = (float*)(ws + WS_SCR); bf16_t* MERGED = (bf16_t*)(ws + WS_MERGED); const bf16_t* GBR = (const bf16_t*)(ws + WS_GBR);
#if MIX_MLSTM
        { pg8::Gemm gm{(const bf16_t*)(ws + WS_OM), (const bf16_t*)(ws + WS_WBM), MG, DM, 512}; pg8::EpiMerge<0> E{GBR, 0, SCR, MERGED};
          pg8::gemm_phase<pg8::EpiMerge<0>, pg8::StaticOrder, true, true>(lds, gm, S, E); }
#endif
#if MIX_GQA
        { pg8::Gemm gm{(const bf16_t*)(ws + WS_QA), (const bf16_t*)(ws + WS_WBA), MG, DM, 1024}; pg8::EpiMerge<MIX_MLSTM ? 1 : 0> E{GBR, 1024, SCR, MERGED};
          pg8::gemm_phase<pg8::EpiMerge<MIX_MLSTM ? 1 : 0>, pg8::StaticOrder, true, true>(lds, gm, S, E); }
#endif
        { constexpr int MODE = (MIX_MLSTM || MIX_GQA) ? 2 : 3;
          pg8::Gemm gm{(const bf16_t*)(ws + WS_QC), (const bf16_t*)(ws + WS_WBC), MG, DM, 512}; pg8::EpiMerge<MODE> E{GBR, 2048, SCR, MERGED};
          pg8::gemm_phase<pg8::EpiMerge<MODE>, pg8::StaticOrder, true, true>(lds, gm, S, E); }
        }
    }
    xcd_barrier(grid);
}

__device__ __forceinline__ int map_win(int n) { return n < 2048 ? n : n + 16; }
__device__ __forceinline__ int map_id(int n) { return n; }
__device__ __forceinline__ int map_up(int n) { return ((n >> 7) & 1) * DFF + (n >> 8) * 128 + (n & 127); }

__device__ __forceinline__ void p0_weights(const Args& a, LAS unsigned char* lds, int gw, int NGW, int wave, int lane, int gtid, int ngt) {
    LAS float* scr = (LAS float*)(lds + wave * 16384);
    unsigned char* ws = a.ws;
#define TRI(W, NSRC, K, NDST, WT, MAP) { constexpr int NI = ((K) / 64) * ((NDST) / 32); if (r < NI) { const int kb = r / ((NDST) / 32), nb = r % ((NDST) / 32); \
        transpose_item(W, NSRC, K, (bf16_t*)(ws + (WT)), 64 * kb, 32 * nb, MAP(32 * nb), scr, lane); continue; } r -= NI; }
    constexpr int NITEMS = 16 * 224 + 16 * 32 + 8 * 32 + 16 * 32 + 8 * 32 + 16 * 32 + 16 * 176 + 44 * 32;
    for (int it = gw; it < NITEMS; it += NGW) {
        int r = it;
        TRI(a.in[6], INW, 1024, NIN, WS_WIN, map_win)
        TRI(a.in[13], 1024, 1024, 1024, WS_WMEM, map_id)
        TRI(a.in[14], 1024, 512, 1024, WS_WBM, map_id)
        TRI(a.in[15], 1024, 1024, 1024, WS_WBA, map_id)
        TRI(a.in[16], 1024, 512, 1024, WS_WBC, map_id)
        TRI(a.in[17], 1024, 1024, 1024, WS_WOUT, map_id)
        TRI(a.in[20], NUP, 1024, NUP, WS_WUP, map_up)
        TRI(a.in[23], 1024, DFF, 1024, WS_WDN, map_id)
    }
#undef TRI
    if (gtid < 64 * 32) { const int pos = gtid >> 5, i = gtid & 31; const float ang = (float)pos * exp2f(-(float)i * (13.287712379549449f / 32.f));
        float sn, cs; sincosf(ang, &sn, &cs); float* tb = (float*)(ws + WS_ROPE); tb[2 * gtid] = cs; tb[2 * gtid + 1] = sn; }
    { bf16_t* wg = (bf16_t*)(ws + WS_WG); const GAS float* win = (const GAS float*)a.in[6];
      for (int i = gtid; i < 16 * 1024; i += ngt) { const int c = i >> 10, k = i & 1023; wg[i] = (bf16_t)(pk2(win[(size_t)k * INW + 2048 + c], 0.f) & 0xffffu); } }
    { bf16_t* mb = (bf16_t*)(ws + WS_MEMB); const int n8p = 8 * NMEM * DM / 8, n8 = 24 * NMEM * DM / 8;
      for (int i = gtid; i < n8; i += ngt) { const GAS f32x4* s = (i < n8p) ? (const GAS f32x4*)a.in[2] + 2 * (size_t)i : (const GAS f32x4*)a.in[3] + 2 * (size_t)(i - n8p);
          const f32x4 x0 = s[0], x1 = s[1]; v4u o; o.x = pk2(x0.x, x0.y); o.y = pk2(x0.z, x0.w); o.z = pk2(x1.x, x1.y); o.w = pk2(x1.z, x1.w); ((GAS v4u*)mb)[i] = o; } }
}

__device__ __forceinline__ void conv_pass(const bf16_t* U1, const bf16_t* U2, bf16_t* HID, const float* cw, const float* cb, int gtid, int ngt) {
    constexpr int CC = DFF / 8, RB = 16, TOTAL = (MG / RB) * CC;
    for (int it = gtid; it < TOTAL; it += ngt) {
        const int cc = it % CC, rb = it / CC, c = 8 * cc, r0 = rb * RB;
        float w1[3][8], w2[3][8], b1[8], b2[8];
#pragma unroll
        for (int j = 0; j < 3; ++j)
#pragma unroll
            for (int e = 0; e < 8; ++e) { w1[j][e] = cw[j * NUP + c + e]; w2[j][e] = cw[j * NUP + DFF + c + e]; }
#pragma unroll
        for (int e = 0; e < 8; ++e) { b1[e] = cb[c + e]; b2[e] = cb[DFF + c + e]; }
        const GAS v4u* p1 = (const GAS v4u*)(U1 + (size_t)r0 * DFF + c); const GAS v4u* p2 = (const GAS v4u*)(U2 + (size_t)r0 * DFF + c);
        constexpr int RS = DFF / 8;
        v4u a1, a2, c1, c2, n1, n2; const v4u z = {0u, 0u, 0u, 0u};
        if ((r0 % SEQ) == 0) { a1 = z; a2 = z; } else { a1 = p1[-RS]; a2 = p2[-RS]; }
        c1 = p1[0]; c2 = p2[0];
#pragma unroll 4
        for (int i = 0; i < RB; ++i) {
            const bool last = (i == RB - 1) && (((r0 + RB) % SEQ) == 0);
            if (last) { n1 = z; n2 = z; } else { n1 = p1[(size_t)(i + 1) * RS]; n2 = p2[(size_t)(i + 1) * RS]; }
            float o[8];
#pragma unroll
            for (int q = 0; q < 4; ++q) {
                const float y1l = w1[0][2 * q] * bflo(a1[q]) + w1[1][2 * q] * bflo(c1[q]) + w1[2][2 * q] * bflo(n1[q]) + b1[2 * q];
                const float y1h = w1[0][2 * q + 1] * bfhi(a1[q]) + w1[1][2 * q + 1] * bfhi(c1[q]) + w1[2][2 * q + 1] * bfhi(n1[q]) + b1[2 * q + 1];
                const float y2l = w2[0][2 * q] * bflo(a2[q]) + w2[1][2 * q] * bflo(c2[q]) + w2[2][2 * q] * bflo(n2[q]) + b2[2 * q];
                const float y2h = w2[0][2 * q + 1] * bfhi(a2[q]) + w2[1][2 * q + 1] * bfhi(c2[q]) + w2[2][2 * q + 1] * bfhi(n2[q]) + b2[2 * q + 1];
                o[2 * q] = gelu_tanh(y1l) * y2l; o[2 * q + 1] = gelu_tanh(y1h) * y2h; }
            v4u w; w.x = pk2(o[0], o[1]); w.y = pk2(o[2], o[3]); w.z = pk2(o[4], o[5]); w.w = pk2(o[6], o[7]);
            *(GAS v4u*)(HID + (size_t)(r0 + i) * DFF + c) = w;
            a1 = c1; a2 = c2; c1 = n1; c2 = n2;
        }
    }
}
#ifndef ENABLE_MIX
#define ENABLE_MIX 0
#endif
__global__ void __launch_bounds__(NTHR, 2) mega_fwd(Args a) {
    extern __shared__ __attribute__((aligned(16))) unsigned char lds_raw[];
    LAS unsigned char* lds = (LAS unsigned char*)lds_raw;
    cg::grid_group grid = cg::this_grid();
    const int G = gridDim.x, NGW = G * NWAVES, ngt = G * NTHR;
    {
        const int tid = threadIdx.x, lane = tid & 63, wave = __builtin_amdgcn_readfirstlane(tid >> 6), bx = blockIdx.x;
        p0_weights(a, lds, bx * NWAVES + wave, NGW, wave, lane, bx * NTHR + tid, ngt);
    }
    unsigned* barw = (unsigned*)(a.ws + WS_CTL);
    if (blockIdx.x == 0) { for (int i = threadIdx.x; i < XCD_BAR_WORDS; i += NTHR) __hip_atomic_store(barw + i, 0u, __ATOMIC_RELAXED, __HIP_MEMORY_SCOPE_AGENT); }
    if (threadIdx.x < 2) ((volatile LAS unsigned*)(lds + BAR_LDS_OFF))[threadIdx.x] = 0u;
    XcdBarrier bar; bar.bar = barw; bar.x = xb_xcc_id(); bar.st = (volatile LAS unsigned*)(lds + BAR_LDS_OFF);
    for (int g = 0; g < NGRP; ++g) {
        int tid_ = threadIdx.x, bx_ = blockIdx.x; asm volatile("" : "+v"(tid_), "+s"(bx_));
        const int tid = tid_, bx = bx_, lane = tid & 63, wave = __builtin_amdgcn_readfirstlane(tid >> 6);
        const int gw = bx * NWAVES + wave, gtid = bx * NTHR + tid;
        unsigned char* ws = a.ws;
        bf16_t* XN = (bf16_t*)(ws + WS_XN); float* STATS = (float*)(ws + WS_STATS);
        const float* xg = (g == 0) ? a.in[0] : a.in[1] + (size_t)(g - 1) * MG * DM;
        float* outg = a.out + (size_t)g * MG * DM;
        for (int m = 2 * gw; m < MG; m += 2 * NGW) ln_row2(xg + (size_t)m * DM, a.in[4], a.in[5], nullptr, XN + (size_t)m * DM, STATS + 2 * m, lane);
        if (g == 0) { __syncthreads(); grid.sync(); if (threadIdx.x == 0) (void)xb_add(&barw[XB_XCNT(bar.x)], 1u); }
        else xcd_barrier(bar);
#if ENABLE_MIX
        mixer_phases(a, lds_raw, g, bar, tid, bx, G);
#endif
        {
#if ENABLE_MIX
            pg8::Gemm gm{(const bf16_t*)(ws + WS_MERGED), (const bf16_t*)(ws + WS_WOUT), MG, DM, DM}; pg8::StaticOrder S; S.init(MG, DM, G, bx);
            pg8::EpiWout E{xg, STATS, a.in[4], a.in[5], outg, ALPHA};
            REPEAT(REP_P5, pg8::gemm_phase<pg8::EpiWout, pg8::StaticOrder, true, true>(lds, gm, S, E);)
#else
            for (int i = gtid; i < MG * DM / 4; i += ngt) { const int row = i >> 8, c4 = i & 255; const f32x4 xv = ((const GAS f32x4*)xg)[i];
                const f32x4 gv = ((const GAS f32x4*)a.in[4])[c4], bv = ((const GAS f32x4*)a.in[5])[c4];
                ((GAS f32x4*)outg)[i] = ((xv - STATS[2 * row]) * STATS[2 * row + 1] * gv + bv) * ALPHA; }
#endif
        }
        xcd_barrier(bar);
        for (int m = 2 * gw; m < MG; m += 2 * NGW) ln_row2(outg + (size_t)m * DM, a.in[18], a.in[19], outg + (size_t)m * DM, XN + (size_t)m * DM, nullptr, lane);
        xcd_barrier(bar);
        {
            pg8::Gemm gm{XN, (const bf16_t*)(ws + WS_WUP), MG, NUP, DM}; pg8::StaticOrder S; S.init(MG, NUP, G, bx);
            pg8::EpiUp E{(bf16_t*)(ws + WS_U1), (bf16_t*)(ws + WS_U2), DFF};
            REPEAT(REP_P6, pg8::gemm_phase<pg8::EpiUp, pg8::StaticOrder, true, true>(lds, gm, S, E);)
        }
        xcd_barrier(bar);
        REPEAT(REP_CONV, conv_pass((const bf16_t*)(ws + WS_U1), (const bf16_t*)(ws + WS_U2), (bf16_t*)(ws + WS_HID), a.in[21], a.in[22], gtid, ngt);)
        xcd_barrier(bar);
        {
            pg8::Gemm gm{(const bf16_t*)(ws + WS_HID), (const bf16_t*)(ws + WS_WDN), MG, DM, DFF}; pg8::StaticOrder S; S.init(MG, DM, G, bx);
            pg8::EpiResF32 E{outg, DM, ALPHA};
            pg8::gemm_phase<pg8::EpiResF32, pg8::StaticOrder, true, true>(lds, gm, S, E);
        }
        xcd_barrier(bar);
        for (int m = 2 * gw; m < MG; m += 2 * NGW) ln_row2(outg + (size_t)m * DM, a.in[24], a.in[25], outg + (size_t)m * DM, nullptr, nullptr, lane);
    }
}

extern "C" void kernel_launch(void* const* d_in, const int* in_sizes, int n_in, void* d_out, int out_size, void* d_ws, size_t ws_size, hipStream_t stream) {
    static int grid = 0;
    if (grid == 0) {
        if (n_in != 26 || ws_size < WS_END || out_size != 3 * MG * DM) { fprintf(stderr, "kernel_launch: unexpected shapes: n_in %d out %d ws %zu (need %zu)\n", n_in, out_size, ws_size, (size_t)WS_END); grid = -1; return; }
        int dev = 0, cus = 0, per_cu = 0;
        if (hipGetDevice(&dev) != hipSuccess || hipDeviceGetAttribute(&cus, hipDeviceAttributeMultiprocessorCount, dev) != hipSuccess) { grid = -1; return; }
        if (hipFuncSetAttribute((const void*)mega_fwd, hipFuncAttributeMaxDynamicSharedMemorySize, LDS_BYTES) != hipSuccess) { fprintf(stderr, "kernel_launch: hipFuncSetAttribute failed\n"); grid = -1; return; }
        if (hipOccupancyMaxActiveBlocksPerMultiprocessor(&per_cu, (const void*)mega_fwd, NTHR, LDS_BYTES) != hipSuccess || per_cu < 1) { fprintf(stderr, "kernel_launch: occupancy query failed (%d)\n", per_cu); per_cu = 1; }
        (void)hipGetLastError();
        grid = cus;
    }
    if (grid < 0) return;
    Args a{};
    for (int i = 0; i < 26; ++i) a.in[i] = (const float*)d_in[i];
    a.out = (float*)d_out; a.ws = (unsigned char*)d_ws;
    void* args[] = {&a};
    hipError_t e = hipLaunchCooperativeKernel((const void*)mega_fwd, dim3(grid), dim3(NTHR), args, LDS_BYTES, stream);
    if (e != hipSuccess) fprintf(stderr, "kernel_launch: cooperative launch failed: %s (grid %d)\n", hipGetErrorString(e), grid);
}
```
